# Optimizing an MI355X kernel written in HIP

```python
import math
import jax
import jax.numpy as jnp
from jax import lax
import numpy as np

D_MODEL = 1024
BATCH = 8
SEQ = 4096
DEPTH = 2

CTX_LEN = 256
GRID_W = 64
HEAD_DIM = 64
ROPE_THETA = 10000.0
Q_BLOCK = 128
EPS = 1e-6
A_HEADS = 8
A_KV_HEADS = 2
B_HEADS = 4
B_QK_DIM = 64
B_V_DIM = 128
C_HEADS = 4
C_DIM = 128
C_CHUNK = 64
CONV_W = 3
D_FF = 2816
N_EXPERTS = 8
TOP_K = 2
D_FF_EXPERT = 1408

IN_SPLITS = (A_HEADS * HEAD_DIM, A_KV_HEADS * HEAD_DIM, A_KV_HEADS * HEAD_DIM,
             B_HEADS * 2 * B_QK_DIM, B_HEADS * 2 * B_QK_DIM, B_HEADS * B_V_DIM,
             C_HEADS * C_DIM, C_HEADS * C_DIM, C_HEADS * C_DIM, C_HEADS * C_DIM, 4 * C_HEADS,
             3 * D_MODEL)
N_IN = sum(IN_SPLITS)

kernel_name = "hybrid_gqa_diffattn_mlstm_moe_dit"


def rms_norm(x, g):
    xf = x.astype(jnp.float32)
    y = xf * lax.rsqrt(jnp.mean(xf * xf, axis=-1, keepdims=True) + EPS)
    return (y * g.astype(jnp.float32)).astype(x.dtype)


def split_heads(x, n):
    b, t, _ = x.shape
    return x.reshape(b, t, n, -1).transpose(0, 2, 1, 3)


def merge_heads(x):
    b, h, t, d = x.shape
    return x.transpose(0, 2, 1, 3).reshape(b, t, h * d)


def split_columns(h):
    out, off = [], 0
    for w in IN_SPLITS:
        out.append(h[..., off:off + w])
        off += w
    return out


def axial_angles(n_tok, dim):
    rows = n_tok // GRID_W
    row = jnp.repeat(jnp.arange(rows, dtype=jnp.float32), GRID_W)
    col = (jnp.arange(n_tok) % GRID_W).astype(jnp.float32)
    n_freq = dim // 4
    inv = ROPE_THETA ** (-jnp.arange(n_freq, dtype=jnp.float32) / n_freq)
    return row[:, None] * inv, col[:, None] * inv


def rope_half(x, ang):
    nf = ang.shape[-1]
    x1, x2 = x[..., :nf], x[..., nf:]
    cs, sn = jnp.cos(ang).astype(x.dtype), jnp.sin(ang).astype(x.dtype)
    return jnp.concatenate([x1 * cs - x2 * sn, x2 * cs + x1 * sn], axis=-1)


def axial_rope(x, ang_r, ang_c):
    h = x.shape[-1] // 2
    return jnp.concatenate([rope_half(x[..., :h], ang_r), rope_half(x[..., h:], ang_c)], axis=-1)


def full_attention(q, k, v, scale):
    s = jnp.einsum('bgrqd,bgkd->bgrqk', q, k, preferred_element_type=jnp.float32) * scale
    p = jax.nn.softmax(s, axis=-1).astype(v.dtype)
    return jnp.einsum('bgrqk,bgkv->bgrqv', p, v)


def block_attention(q, k, v, kc, vc, scale):
    k_all = jnp.concatenate([kc, k], axis=2)
    v_all = jnp.concatenate([vc, v], axis=2)
    b, g, r, t, d = q.shape
    nb = t // Q_BLOCK
    qb = jnp.moveaxis(q.reshape(b, g, r, nb, Q_BLOCK, d), 3, 0)
    o = lax.map(lambda qq: full_attention(qq, k_all, v_all, scale), qb)
    return jnp.moveaxis(o, 0, 3).reshape(b, g, r, t, -1)


def gqa_mixer(pl, pc, q_g, k_g, angs, with_ctx):
    def prep(q, k, v):
        return (rms_norm(split_heads(q, A_HEADS), q_g), rms_norm(split_heads(k, A_KV_HEADS), k_g),
                split_heads(v, A_KV_HEADS))
    ql, kl, vl = prep(*pl)
    qc, kc, vc = prep(*pc)
    ql = axial_rope(ql, *angs)
    kl = axial_rope(kl, *angs)
    rep = A_HEADS // A_KV_HEADS

    def group(q):
        b, h, t, d = q.shape
        return q.reshape(b, A_KV_HEADS, rep, t, d)

    def ungroup(o):
        b, g, r, t, d = o.shape
        return merge_heads(o.reshape(b, g * r, t, d))
    scale = HEAD_DIM ** -0.5
    out_l = ungroup(block_attention(group(ql), kl, vl, kc, vc, scale))
    out_c = ungroup(full_attention(group(qc), kc, vc, scale)) if with_ctx else None
    return out_l, out_c


def diff_mixer(pl, pc, lam_vecs, sub_g, lam_init, angs, with_ctx):
    def prep(q, k, v):
        return (split_heads(q, 2 * B_HEADS), split_heads(k, 2 * B_HEADS),
                jnp.repeat(split_heads(v, B_HEADS), 2, axis=1))
    ql, kl, vl = prep(*pl)
    qc, kc, vc = prep(*pc)
    ql = axial_rope(ql, *angs)
    kl = axial_rope(kl, *angs)
    lq1, lk1, lq2, lk2 = [a.astype(jnp.float32) for a in lam_vecs]
    lam = jnp.exp(jnp.sum(lq1 * lk1)) - jnp.exp(jnp.sum(lq2 * lk2)) + lam_init
    scale = B_QK_DIM ** -0.5

    def combine(o):
        b, _, _, t, dv = o.shape
        o = o.reshape(b, B_HEADS, 2, t, dv).astype(jnp.float32)
        dif = o[:, :, 0] - lam * o[:, :, 1]
        dif = rms_norm(dif, sub_g) * (1.0 - lam_init)
        return merge_heads(dif.astype(vl.dtype))
    out_l = combine(block_attention(ql[:, :, None], kl, vl, kc, vc, scale))
    out_c = combine(full_attention(qc[:, :, None], kc, vc, scale)) if with_ctx else None
    return out_l, out_c


def centred_conv(x, w, b):
    k = w.shape[0]
    p = k // 2
    t = x.shape[1]
    xp = jnp.pad(x, ((0, 0), (p, k - 1 - p), (0, 0)))
    y = xp[:, 0:t] * w[0]
    for j in range(1, k):
        y = y + xp[:, j:j + t] * w[j]
    return y + b


def mlstm_chunk_scan(q, k, v, i_pre, logf, state):
    b, h, t, dk = q.shape
    dv = v.shape[-1]
    L = C_CHUNK
    nc = t // L

    def chunks(a):
        return jnp.moveaxis(a.reshape((b, h, nc, L) + a.shape[3:]), 2, 0)
    xs = (chunks(q), chunks(k), chunks(v), chunks(i_pre), chunks(logf))
    tri = jnp.tril(jnp.ones((L, L), dtype=bool))

    def step(carry, inp):
        C, n, m = carry
        qc, kc, vc, ic, fc = inp
        bcum = jnp.cumsum(fc, axis=-1)
        logD = bcum[..., :, None] - bcum[..., None, :] + ic[..., None, :]
        logD = jnp.where(tri, logD, -jnp.inf)
        inter = bcum + m[..., None]
        m_t = jnp.maximum(inter, jnp.max(logD, axis=-1))
        dmat = jnp.exp(logD - m_t[..., None])
        a_inter = jnp.exp(inter - m_t)
        s = jnp.einsum('bhtd,bhsd->bhts', qc, kc, preferred_element_type=jnp.float32) * dmat
        num = a_inter[..., None] * jnp.einsum('bhvd,bhtd->bhtv', C, qc) + jnp.einsum('bhts,bhsv->bhtv', s, vc)
        den = a_inter * jnp.einsum('bhd,bhtd->bht', n, qc) + jnp.sum(s, axis=-1)
        hc = num / jnp.maximum(jnp.abs(den), jnp.exp(-m_t))[..., None]
        b_last = bcum[..., -1]
        w_log = b_last[..., None] - bcum + ic
        m_new = jnp.maximum(b_last + m, jnp.max(w_log, axis=-1))
        decay = jnp.exp(b_last + m - m_new)
        ws = jnp.exp(w_log - m_new[..., None])
        C_new = decay[..., None, None] * C + jnp.einsum('bhs,bhsv,bhsd->bhvd', ws, vc, kc)
        n_new = decay[..., None] * n + jnp.einsum('bhs,bhsd->bhd', ws, kc)
        return (C_new, n_new, m_new), hc
    state, hs = lax.scan(step, state, xs)
    return jnp.moveaxis(hs, 0, 2).reshape(b, h, t, dv).astype(v.dtype), state


def mlstm_mixer(pl, pc, conv_w, conv_b, gate_b, norm_g, with_ctx):
    def prep(q_pre, k_pre, v, o_pre, g_pre):
        b, t, _ = v.shape
        qk = jax.nn.silu(centred_conv(jnp.concatenate([q_pre, k_pre], axis=-1), conv_w, conv_b))
        q = split_heads(qk[..., :C_HEADS * C_DIM], C_HEADS)
        k = split_heads(qk[..., C_HEADS * C_DIM:], C_HEADS) * (C_DIM ** -0.5)
        vh = split_heads(v, C_HEADS)
        g = (g_pre.astype(jnp.float32) + gate_b.astype(jnp.float32)).reshape(b, t, 4, C_HEADS)
        g = g.transpose(2, 0, 3, 1)
        fwd = (g[0], jax.nn.log_sigmoid(g[1]))
        bwd = (g[2], jax.nn.log_sigmoid(g[3]))
        return q, k, vh, o_pre, fwd, bwd
    ql, kl, vl, ol, fl, bl = prep(*pl)
    qc, kc, vc, oc, fc, bc = prep(*pc)

    def flip(a):
        return jnp.flip(a, axis=2)

    def run(q, k, v, gates, state, reverse):
        if reverse:
            hh, st = mlstm_chunk_scan(flip(q), flip(k), flip(v), flip(gates[0]), flip(gates[1]), state)
            return flip(hh), st
        return mlstm_chunk_scan(q, k, v, gates[0], gates[1], state)
    bsz = qc.shape[0]
    zero = (jnp.zeros((bsz, C_HEADS, C_DIM, C_DIM), jnp.float32),
            jnp.zeros((bsz, C_HEADS, C_DIM), jnp.float32),
            jnp.zeros((bsz, C_HEADS), jnp.float32))
    hcf, st_f = run(qc, kc, vc, fc, zero, False)
    hcb, st_b = run(qc, kc, vc, bc, zero, True)
    hlf, _ = run(ql, kl, vl, fl, st_f, False)
    hlb, _ = run(ql, kl, vl, bl, st_b, True)

    def out(hf, hb, o_pre):
        return merge_heads(rms_norm(hf + hb, norm_g)) * jax.nn.sigmoid(o_pre)
    out_l = out(hlf, hlb, ol)
    out_c = out(hcf, hcb, oc) if with_ctx else None
    return out_l, out_c


def token_mixer(xl, xc, angs, lam_init, with_ctx, w_in, q_g, k_g, lq1, lk1, lq2, lk2, diff_g,
                conv_w, conv_b, gate_b, mlstm_g, w_br_a, w_br_b, w_br_c, w_out):
    cl = split_columns(xl @ w_in)
    cc = split_columns(xc @ w_in)
    a_l, a_c = gqa_mixer(cl[0:3], cc[0:3], q_g, k_g, angs, with_ctx)
    b_l, b_c = diff_mixer(cl[3:6], cc[3:6], (lq1, lk1, lq2, lk2), diff_g, lam_init, angs, with_ctx)
    m_l, m_c = mlstm_mixer(cl[6:11], cc[6:11], conv_w, conv_b, gate_b, mlstm_g, with_ctx)

    def merge(a, b, m, gate_pre):
        g_a, g_b, g_m = jnp.split(jax.nn.sigmoid(gate_pre.astype(jnp.float32)).astype(a.dtype), 3, axis=-1)
        return (g_a * (a @ w_br_a) + g_b * (b @ w_br_b) + g_m * (m @ w_br_c)) @ w_out
    y_l = merge(a_l, b_l, m_l, cl[11])
    y_c = merge(a_c, b_c, m_c, cc[11]) if with_ctx else None
    return y_l, y_c


def swiglu(x, wg, wu, wd):
    return (jax.nn.silu(x @ wg) * (x @ wu)) @ wd


def moe_swiglu(x, w_r, b_r, wg, wu, wd):
    shp = x.shape
    xt = x.reshape(-1, shp[-1])
    logits = (xt @ w_r).astype(jnp.float32) + b_r.astype(jnp.float32)
    top_v, top_i = lax.top_k(logits, TOP_K)
    top_w = jax.nn.softmax(top_v, axis=-1)
    gates = jnp.sum(top_w[..., None] * jax.nn.one_hot(top_i, N_EXPERTS, dtype=jnp.float32), axis=1)
    out = jnp.zeros_like(xt)
    for e in range(N_EXPERTS):
        out = out + gates[:, e:e + 1].astype(xt.dtype) * swiglu(xt, wg[e], wu[e], wd[e])
    return out.reshape(shp)


def setup_inputs(seed: int = 0) -> dict:
    key = jax.random.key(seed)
    ks = iter(jax.random.split(key, 48))
    f32 = jnp.float32
    D = D_MODEL
    L = DEPTH
    nd = (DEPTH + 1) // 2
    nm = DEPTH // 2

    def nrm(shape, scale):
        return jax.random.normal(next(ks), shape, f32) * scale

    def gain(shape):
        return 1.0 + nrm(shape, 0.05)
    i_bias = nrm((L, 2, C_HEADS), 0.1)
    f_bias = jnp.linspace(3.0, 6.0, C_HEADS, dtype=f32)[None, None, :] + nrm((L, 2, C_HEADS), 0.1)
    gate_b = jnp.stack([i_bias[:, 0], f_bias[:, 0], i_bias[:, 1], f_bias[:, 1]], axis=1).reshape(L, 4 * C_HEADS)
    return {
        "x": nrm((BATCH, SEQ, D), 1.0),
        "c": nrm((BATCH, D), 1.0),
        "ctx": nrm((BATCH, CTX_LEN, D), 1.0),
        "c_ctx": nrm((D,), 1.0),
        "ada_w": nrm((L, D, 6 * D), 0.5 * D ** -0.5),
        "ada_b": nrm((L, 6 * D), 0.02),
        "pre_mix_g": gain((L, D)),
        "post_mix_g": gain((L, D)),
        "pre_ffn_g": gain((L, D)),
        "post_ffn_g": gain((L, D)),
        "w_in": nrm((L, D, N_IN), D ** -0.5),
        "q_norm_g": gain((L, HEAD_DIM)),
        "k_norm_g": gain((L, HEAD_DIM)),
        "lam_q1": nrm((L, B_QK_DIM), 0.1),
        "lam_k1": nrm((L, B_QK_DIM), 0.1),
        "lam_q2": nrm((L, B_QK_DIM), 0.1),
        "lam_k2": nrm((L, B_QK_DIM), 0.1),
        "diff_norm_g": gain((L, B_V_DIM)),
        "conv_w": nrm((L, CONV_W, 2 * C_HEADS * C_DIM), CONV_W ** -0.5),
        "conv_b": nrm((L, 2 * C_HEADS * C_DIM), 0.02),
        "mlstm_gate_b": gate_b,
        "mlstm_norm_g": gain((L, C_DIM)),
        "w_br_attn": nrm((L, A_HEADS * HEAD_DIM, D), (A_HEADS * HEAD_DIM) ** -0.5),
        "w_br_diff": nrm((L, B_HEADS * B_V_DIM, D), (B_HEADS * B_V_DIM) ** -0.5),
        "w_br_mlstm": nrm((L, C_HEADS * C_DIM, D), (C_HEADS * C_DIM) ** -0.5),
        "w_out": nrm((L, D, D), D ** -0.5),
        "w_ff_gate": nrm((nd, D, D_FF), D ** -0.5),
        "w_ff_up": nrm((nd, D, D_FF), D ** -0.5),
        "w_ff_down": nrm((nd, D_FF, D), D_FF ** -0.5),
        "w_router": nrm((nm, D, N_EXPERTS), D ** -0.5),
        "b_router": nrm((nm, N_EXPERTS), 0.01),
        "w_moe_gate": nrm((nm, N_EXPERTS, D, D_FF_EXPERT), D ** -0.5),
        "w_moe_up": nrm((nm, N_EXPERTS, D, D_FF_EXPERT), D ** -0.5),
        "w_moe_down": nrm((nm, N_EXPERTS, D_FF_EXPERT, D), D_FF_EXPERT ** -0.5),
    }


def reference(x, c, ctx, c_ctx, ada_w, ada_b, pre_mix_g, post_mix_g, pre_ffn_g, post_ffn_g, w_in,
              q_norm_g, k_norm_g, lam_q1, lam_k1, lam_q2, lam_k2, diff_norm_g, conv_w, conv_b,
              mlstm_gate_b, mlstm_norm_g, w_br_attn, w_br_diff, w_br_mlstm, w_out, w_ff_gate, w_ff_up,
              w_ff_down, w_router, b_router, w_moe_gate, w_moe_up, w_moe_down):
    n_tok = x.shape[1]
    angs = axial_angles(n_tok, HEAD_DIM)
    for l in range(DEPTH):
        last = l == DEPTH - 1
        lam_init = 0.8 - 0.6 * math.exp(-0.3 * l)
        mod = jax.nn.silu(c) @ ada_w[l] + ada_b[l]
        mod_c = jax.nn.silu(c_ctx) @ ada_w[l] + ada_b[l]
        sh1, sc1, g1, sh2, sc2, g2 = jnp.split(mod[:, None, :], 6, axis=-1)
        sh1c, sc1c, g1c, sh2c, sc2c, g2c = jnp.split(mod_c, 6)
        xn = rms_norm(x, pre_mix_g[l]) * (1.0 + sc1) + sh1
        cn = rms_norm(ctx, pre_mix_g[l]) * (1.0 + sc1c) + sh1c
        y, yc = token_mixer(xn, cn, angs, lam_init, not last, w_in[l], q_norm_g[l], k_norm_g[l],
                            lam_q1[l], lam_k1[l], lam_q2[l], lam_k2[l], diff_norm_g[l], conv_w[l], conv_b[l],
                            mlstm_gate_b[l], mlstm_norm_g[l], w_br_attn[l], w_br_diff[l], w_br_mlstm[l], w_out[l])
        x = x + g1 * rms_norm(y, post_mix_g[l])
        if not last:
            ctx = ctx + g1c * rms_norm(yc, post_mix_g[l])

        def channel(h):
            if l % 2 == 0:
                j = l // 2
                return swiglu(h, w_ff_gate[j], w_ff_up[j], w_ff_down[j])
            j = l // 2
            return moe_swiglu(h, w_router[j], b_router[j], w_moe_gate[j], w_moe_up[j], w_moe_down[j])
        xn = rms_norm(x, pre_ffn_g[l]) * (1.0 + sc2) + sh2
        x = x + g2 * rms_norm(channel(xn), post_ffn_g[l])
        if not last:
            cn = rms_norm(ctx, pre_ffn_g[l]) * (1.0 + sc2c) + sh2c
            ctx = ctx + g2c * rms_norm(channel(cn), post_ffn_g[l])
    return x
```

```cpp
#include <hip/hip_runtime.h>
#include <cstdio>
#include <cstdint>

#ifndef PROBE_ML
#define PROBE_ML 1
#endif
#ifndef PROBE_DUP
#define PROBE_DUP 0
#endif
#define REP(j) for (int rep_ = 0; rep_ < ((((PROBE_DUP) >> (j)) & 1) ? 2 : 1); ++rep_)
#ifndef MK_SINGLE
#define MK_SINGLE 1
#endif

#define LAS __attribute__((address_space(3)))
typedef unsigned short bf16;
typedef short bf16x8 __attribute__((ext_vector_type(8)));
typedef float f32x4 __attribute__((ext_vector_type(4)));
typedef float f32x16 __attribute__((ext_vector_type(16)));
typedef unsigned u32x4 __attribute__((ext_vector_type(4)));
typedef unsigned u32x2 __attribute__((ext_vector_type(2)));
typedef float f32x2_t __attribute__((ext_vector_type(2)));
typedef __bf16 bf16x2_t __attribute__((ext_vector_type(2)));

constexpr int NB = 8, TLAT = 4096, NCTX = 256, SEQ = NCTX + TLAT  , R = NB * SEQ  ;
constexpr int D = 1024, NIN = 7440, NP = 4352  ;
constexpr int DFF = 2816, NEXP = 8, DFE = 1408;
constexpr int PA_Q = 0, PA_K = 512, PA_V = 640, PB_Q = 768, PB_K = 1280, PB_V = 1792, PC_Q = 2304, PC_K = 2816, PC_V = 3328, PC_O = 3840;
constexpr float EPS = 1e-6f;
constexpr float C2 = 0.125f * 1.4426950408889634f;
constexpr int NWAVES = 8, NTHR = 512;

constexpr size_t MiB = 1u << 20;
constexpr size_t WS_CTL = 0, CTL_BYTES = 1 * MiB;
constexpr size_t WS_MOD = 1 * MiB;
constexpr size_t WS_ROPE = WS_MOD + 512 * 1024;
constexpr size_t WS_GATES = 2 * MiB;
constexpr size_t WS_MOE = 5 * MiB;
constexpr size_t WS_CTXRES = 7 * MiB;
constexpr size_t WS_W = 15 * MiB;
constexpr size_t W_IN = WS_W, W_G = W_IN + (size_t)NP * D * 2, W_A = W_G + (size_t)3072 * D * 2, W_B = W_A + (size_t)1024 * 512 * 2, W_C = W_B + (size_t)1024 * 512 * 2,
                 W_O = W_C + (size_t)1024 * 512 * 2, W_END = W_O + (size_t)D * D * 2;
static_assert(W_END <= 35 * MiB && W_B - W_A == MiB && W_C - W_B == MiB, "W region");
constexpr size_t WS_R0 = 35 * MiB;
constexpr size_t WS_R2 = 103 * MiB;
constexpr size_t WS_R1 = 205 * MiB;
constexpr size_t WS_CQK = WS_R2;
constexpr size_t WS_END = 494 * MiB;
constexpr size_t SZ_RD = (size_t)R * D * 2;
static_assert(SZ_RD == 68 * MiB && (size_t)R * NP * 2 == 289 * MiB, "sizes");
constexpr size_t WS_AO = WS_R2, WS_BO = WS_R2 + 34 * MiB, WS_MO = WS_R2 + 68 * MiB;
constexpr size_t WS_G = WS_R1, WS_U = WS_R1 + 204 * MiB, WS_Y = WS_R1, WS_H = WS_R1;
constexpr size_t WS_Y2 = WS_R2;
constexpr size_t WS_WFF = 171 * MiB;
constexpr size_t WFF_GU = WS_WFF, WFF_D = WS_WFF + (size_t)2 * DFF * D * 2;
static_assert(WFF_D + (size_t)D * DFF * 2 <= WS_R1, "ffn weights inside R2");
constexpr int XG_ROWS = 2 * NB * TLAT + NEXP * 256;
constexpr size_t WS_XG = WS_R2;
constexpr size_t WS_YS = WS_R2;
constexpr size_t WS_HM = 235 * MiB;
constexpr size_t WS_WM = 417 * MiB;
constexpr size_t WM_GU = WS_WM, WM_D = WS_WM + (size_t)NEXP * 2 * DFE * D * 2;
static_assert(WS_XG + (size_t)XG_ROWS * D * 2 <= WS_HM && WS_HM + (size_t)XG_ROWS * DFE * 2 <= WS_WM && WM_D + (size_t)NEXP * D * DFE * 2 <= WS_END, "moe map");
constexpr size_t MOE_TOKE = WS_MOE, MOE_TOKP = MOE_TOKE + 2 * 32768 * 4, MOE_TOKW = MOE_TOKP + 2 * 32768 * 4, MOE_ROWSLOT = MOE_TOKW + 2 * 32768 * 4, MOE_ROWW = MOE_ROWSLOT + (size_t)XG_ROWS * 4;
static_assert(MOE_ROWW + (size_t)XG_ROWS * 4 <= WS_CTXRES, "moe lists");
constexpr int CW_BAR = 4096;
constexpr int CW_CNT = 16384;

constexpr int RING_BYTES = 131072;
constexpr int MISC_OFF = RING_BYTES + 320;
constexpr int LDS_BYTES = 147456;
constexpr int PTAB_OFF = RING_BYTES + 1024;

__device__ __forceinline__ unsigned cvtpk(float lo, float hi) { f32x2_t v = {lo, hi}; bf16x2_t b = __builtin_convertvector(v, bf16x2_t); return __builtin_bit_cast(unsigned, b); }
__device__ __forceinline__ bf16 f2bf(float f) { return (bf16)(cvtpk(f, 0.f) & 0xffffu); }
__device__ __forceinline__ float bflo(unsigned w) { return __uint_as_float(w << 16); }
__device__ __forceinline__ float bfhi(unsigned w) { return __uint_as_float(w & 0xffff0000u); }
__device__ __forceinline__ float bf2f(bf16 h) { return __uint_as_float(((unsigned)h) << 16); }
__device__ __forceinline__ float sigmoidf_(float x) { return __builtin_amdgcn_rcpf(1.f + __builtin_amdgcn_exp2f(-1.4426950408889634f * x)); }
__device__ __forceinline__ float invsigmoidf_(float x) { return 1.f + __builtin_amdgcn_exp2f(fminf(-1.4426950408889634f * x, 20.f)); }
__device__ __forceinline__ float siluf_(float x) { return x * __builtin_amdgcn_rcpf(1.f + __builtin_amdgcn_exp2f(-1.4426950408889634f * x)); }
__device__ __forceinline__ float logsigmoidf_(float x) { const float e = __expf(-fabsf(x)); const float l1p = (e < 1e-4f) ? e * (1.f - 0.5f * e) : __logf(1.f + e); return fminf(x, 0.f) - l1p; }
__device__ __forceinline__ float dpp_add(float v, const int ctrl_sel) {
    int r;
    if (ctrl_sel == 0) r = __builtin_amdgcn_update_dpp(0, __builtin_bit_cast(int, v), 0xB1, 0xF, 0xF, true);
    else if (ctrl_sel == 1) r = __builtin_amdgcn_update_dpp(0, __builtin_bit_cast(int, v), 0x4E, 0xF, 0xF, true);
    else if (ctrl_sel == 2) r = __builtin_amdgcn_update_dpp(0, __builtin_bit_cast(int, v), 0x141, 0xF, 0xF, true);
    else r = __builtin_amdgcn_update_dpp(0, __builtin_bit_cast(int, v), 0x140, 0xF, 0xF, true);
    return v + __builtin_bit_cast(float, r);
}
__device__ __forceinline__ float row16_sum(float v) { v = dpp_add(v, 0); v = dpp_add(v, 1); v = dpp_add(v, 2); v = dpp_add(v, 3); return v; }
__device__ __forceinline__ float wave_sum(float v) {
    v = row16_sum(v);
    const int iv = __builtin_bit_cast(int, v);
    const float a = __builtin_bit_cast(float, __builtin_amdgcn_readlane(iv, 0)), b = __builtin_bit_cast(float, __builtin_amdgcn_readlane(iv, 16));
    const float c = __builtin_bit_cast(float, __builtin_amdgcn_readlane(iv, 32)), d = __builtin_bit_cast(float, __builtin_amdgcn_readlane(iv, 48));
    return (a + b) + (c + d);
}

#define XB_TMO      128
#define XB_XCNT(j)  (256  + 64 * (j))
#define XB_XSUB(j)  (1280 + 64 * (j))
#define XB_XGEN(j)  (2304 + 64 * (j))
#define XB_TOP      3328
#define XB_TOPGEN   3392
#define XCD_BAR_WORDS 3456
#define XB_SPIN_CAP (1u << 18)
__device__ __forceinline__ unsigned xb_ld(unsigned* p)              { return __hip_atomic_load(p, __ATOMIC_RELAXED, __HIP_MEMORY_SCOPE_AGENT); }
__device__ __forceinline__ unsigned xb_add(unsigned* p, unsigned v) { return __hip_atomic_fetch_add(p, v, __ATOMIC_RELAXED, __HIP_MEMORY_SCOPE_AGENT); }
__device__ __forceinline__ unsigned xb_xcc_id() { return (unsigned)__builtin_amdgcn_s_getreg((3 << 11) | 20) & 0xFu; }
#define XB_SPIN(cond, bar) do { unsigned _sp = 0; while (cond) { __builtin_amdgcn_s_sleep(1); \
    if ((++_sp & 255u) == 0u) { if (xb_ld(&(bar)[XB_TMO])) break; if (_sp > XB_SPIN_CAP) { atomicAdd(&(bar)[XB_TMO], 1u); break; } } } } while (0)
struct XcdBarrier { unsigned* bar; unsigned x; volatile LAS unsigned* st; };
__device__ __forceinline__ XcdBarrier xcd_barrier_post(unsigned* bar, volatile LAS unsigned* st) {
    XcdBarrier b; b.bar = bar; b.x = xb_xcc_id(); b.st = st;
    if (threadIdx.x == 0) (void)xb_add(&bar[XB_XCNT(b.x)], 1u);
    return b;
}
__device__ __forceinline__ void xcd_barrier_complete(unsigned* bar, unsigned x, unsigned& nloc, unsigned& nx) {
    const unsigned G = gridDim.x * gridDim.y * gridDim.z;
    unsigned sum, cnt, mine, sp = 0u;
    for (;;) {
        sum = 0u; cnt = 0u; mine = 0u;
#pragma unroll
        for (unsigned j = 0; j < 16; ++j) { const unsigned c = xb_ld(&bar[XB_XCNT(j)]); sum += c; cnt += (c > 0u) ? 1u : 0u; mine = (j == x) ? c : mine; }
        if (sum == G) break;
        __builtin_amdgcn_s_sleep(1);
        if ((++sp & 255u) == 0u) { if (xb_ld(&bar[XB_TMO])) break; if (sp > XB_SPIN_CAP) { atomicAdd(&bar[XB_TMO], 1u); break; } }
    }
    nloc = mine > 0u ? mine : 1u; nx = cnt > 0u ? cnt : 1u;
}
__device__ __forceinline__ void xcd_barrier(const XcdBarrier& b) {
    asm volatile("s_waitcnt vmcnt(0)" ::: "memory");
    __syncthreads();
    if (threadIdx.x == 0) {
        unsigned* bar = b.bar;
        __builtin_amdgcn_s_waitcnt(0);
        unsigned nloc = b.st[0], nx = b.st[1];
        if (nloc == 0u) { xcd_barrier_complete(bar, b.x, nloc, nx); b.st[0] = nloc; b.st[1] = nx; }
        const unsigned old = xb_add(&bar[XB_XSUB(b.x)], 1u);
        const unsigned gen = old / nloc;
        if (old + 1u == (gen + 1u) * nloc) {
            __builtin_amdgcn_fence(__ATOMIC_RELEASE, "agent");
            asm volatile("s_waitcnt vmcnt(0)" ::: "memory");
            const unsigned og = xb_add(&bar[XB_TOP], 1u);
            const unsigned tg = og / nx;
            if (og + 1u == (tg + 1u) * nx) xb_add(&bar[XB_TOPGEN], 1u);
            else XB_SPIN(xb_ld(&bar[XB_TOPGEN]) == tg, bar);
            __builtin_amdgcn_fence(__ATOMIC_ACQUIRE, "agent");
            xb_add(&bar[XB_XGEN(b.x)], 1u);
            asm volatile("s_waitcnt vmcnt(0)" ::: "memory");
        } else {
            XB_SPIN(xb_ld(&bar[XB_XGEN(b.x)]) == gen, bar);
            __builtin_amdgcn_fence(__ATOMIC_ACQUIRE, "agent");
            asm volatile("s_waitcnt vmcnt(0)" ::: "memory");
        }
    }
    __syncthreads();
}

namespace pg8 {
constexpr int BM = 256, BK = 64, HALF = 128, HTB = HALF * BK * 2, STAGE_BYTES = 8 * HTB, NXCD = 8, WGM = 8;
__host__ __device__ __forceinline__ int lds_byte(int r, int c) { const int st = (r >> 4) * 2 + (c >> 5), rr = r & 15, cc = c & 31, ob = rr * 64 + cc * 2; return st * 1024 + (ob ^ (((ob >> 9) & 1) << 5)); }
__host__ __device__ __forceinline__ void stage_rc(int b, int& Rr, int& C) { const int st = b / 1024, sb = b % 1024, swz = sb ^ (((sb >> 9) & 1) << 5); Rr = (st >> 1) * 16 + swz / 64; C = (st & 1) * 32 + (swz % 64) / 2; }

struct Unit { int pm, pn, aux; const char* a; const char* b; };
struct GemmP { int K, lda, ldb; };

__device__ __forceinline__ void tile_of(int L, int nM, int nN, int& pm, int& pn) {
    const int nwg = nM * nN;
    int wgid = L; { const int q = nwg / NXCD, r = nwg % NXCD, xcd = wgid % NXCD, off = wgid / NXCD; wgid = (xcd < r ? xcd * (q + 1) : r * (q + 1) + (xcd - r) * q) + off; }
    const int nig = WGM * nN, gid = wgid / nig, fm = gid * WGM, gsz = (nM - fm) < WGM ? (nM - fm) : WGM;
    pm = fm + ((wgid % nig) % gsz); pn = (wgid % nig) / gsz;
}
struct StaticOrder {
    static constexpr bool CHAIN = false;
    int nM, nN, nwg, G, c, lat; const char* A; const char* B; size_t ta, tb;
    __device__ void init(int M, int N, int G_, int c_, const void* A_, int lda, const void* B_, int ldb, int lat_ = 0) { nM = M / BM; if (lat_) nM = nM / 17 * 16; nN = N / BM; nwg = nM * nN; G = G_; c = c_; lat = lat_; A = (const char*)A_; B = (const char*)B_; ta = (size_t)BM * lda * 2; tb = (size_t)BM * ldb * 2; }
    __device__ __forceinline__ bool next(int i, Unit& u) const {
        const long L = (long)i * G + c; if (L >= nwg) return false;
        tile_of((int)L, nM, nN, u.pm, u.pn); if (lat) u.pm += (u.pm >> 4) + 1; u.aux = 0; u.a = A + (size_t)u.pm * ta; u.b = B + (size_t)u.pn * tb; return true;
    }
};

template <class Epi, class Sched>
__device__ __forceinline__ void gemm_phase(LAS unsigned char* lds, const GemmP g, const Sched& S, const Epi& E) {
    int tid_ = threadIdx.x; asm volatile("" : "+v"(tid_));
    const int tid = tid_, wid = __builtin_amdgcn_readfirstlane(tid >> 6), lane = tid & 63, wr = wid >> 2, wc = wid & 3, fr = lane & 15, fq = lane >> 4;
    const int K = g.K, nt = K / BK;
    unsigned voffA[2], voffB[2];
#pragma unroll
    for (int i = 0; i < 2; ++i) { int Rr, C; stage_rc(tid * 16 + i * 8192, Rr, C); voffA[i] = (unsigned)(Rr * g.lda + C) * 2u; voffB[i] = (unsigned)(Rr * g.ldb + C) * 2u; }
    const size_t kstep = (size_t)(BK * 2);
    const size_t hstepA = (size_t)HALF * g.lda * 2, hstepB = (size_t)HALF * g.ldb * 2;
    const unsigned ldsw = (unsigned)wid * 1024u;
    const int aoff = lds_byte(wr * 64 + fr, fq * 8), boff = lds_byte(wc * 32 + fr, fq * 8);
#define PG8_SA(b, h) (((b) * 2 + (h)) * HTB)
#define PG8_SB(b, h) ((4 + (b) * 2 + (h)) * HTB)
#define PG8_STAGE(bufoff, gbase, voff) do { _Pragma("unroll") for (int _i = 0; _i < 2; ++_i) \
        __builtin_amdgcn_global_load_lds((const unsigned*)((const char*)(gbase) + (voff)[_i]), (LAS unsigned*)(lds + (bufoff) + ldsw + _i * 8192), 16, 0, 0); } while (0)
#define PG8_LDA(dst, b, h) do { _Pragma("unroll") for (int m = 0; m < 4; ++m) _Pragma("unroll") for (int k = 0; k < 2; ++k) dst[m][k] = *(const LAS bf16x8*)(lds + PG8_SA(b, h) + aoff + m * 2048 + k * 1024); } while (0)
#define PG8_LDB(dst, b, h) do { _Pragma("unroll") for (int n = 0; n < 2; ++n) _Pragma("unroll") for (int k = 0; k < 2; ++k) dst[n][k] = *(const LAS bf16x8*)(lds + PG8_SB(b, h) + boff + n * 2048 + k * 1024); } while (0)
#define PG8_MMA(ai, bj, At, Bt) do { __builtin_amdgcn_s_setprio(1); _Pragma("unroll") for (int m = 0; m < 4; ++m) _Pragma("unroll") for (int n = 0; n < 2; ++n) _Pragma("unroll") for (int k = 0; k < 2; ++k) \
        acc[ai][bj][m][n] = __builtin_amdgcn_mfma_f32_16x16x32_bf16(Bt[n][k], At[m][k], acc[ai][bj][m][n], 0, 0, 0); __builtin_amdgcn_s_setprio(0); } while (0)
#define PG8_WAIT_V(n) asm volatile("s_waitcnt vmcnt(" #n ")" ::: "memory")
#define PG8_WAIT_L(n) asm volatile("s_waitcnt lgkmcnt(" #n ")" ::: "memory")
#define PG8_BAR __builtin_amdgcn_s_barrier()
#define PG8_SCHED __builtin_amdgcn_sched_barrier(0)
    Unit cur, nxt; int ui = 0;
    if (!S.next(0, cur)) return;
    f32x4 acc[2][2][4][2];
#pragma unroll
    for (int a = 0; a < 2; ++a)
#pragma unroll
        for (int b = 0; b < 2; ++b)
#pragma unroll
            for (int m = 0; m < 4; ++m)
#pragma unroll
                for (int n = 0; n < 2; ++n) acc[a][b][m][n] = (f32x4){0.f, 0.f, 0.f, 0.f};
    bf16x8 At[4][2], B0[2][2], B1[2][2];
    const char* cA = cur.a; const char* cB = cur.b;
    PG8_STAGE(PG8_SB(0, 0), cB, voffB); PG8_STAGE(PG8_SB(0, 1), cB + hstepB, voffB); PG8_STAGE(PG8_SA(0, 0), cA, voffA); PG8_STAGE(PG8_SA(0, 1), cA + hstepA, voffA);
    if (wr == 1) PG8_BAR;
    PG8_WAIT_V(2); PG8_BAR;
    PG8_STAGE(PG8_SB(1, 0), cB + kstep, voffB); PG8_STAGE(PG8_SA(1, 0), cA + kstep, voffA); PG8_STAGE(PG8_SB(1, 1), cB + hstepB + kstep, voffB);
    PG8_WAIT_V(6); PG8_BAR;
    for (;;) {
        const bool has_next = S.next(ui + 1, nxt);
        const char* nA = has_next ? nxt.a : cA; const char* nB = has_next ? nxt.b : cB;
        for (int t = 0; t < nt; t += 2) {
            const bool last = (t == nt - 2);
            const char* a1 = cA + (size_t)(t + 1) * kstep;
            const char* a2 = last ? nA : cA + (size_t)(t + 2) * kstep; const char* b2 = last ? nB : cB + (size_t)(t + 2) * kstep;
            const char* a3 = a2 + kstep; const char* b3 = b2 + kstep;
            PG8_LDB(B0, 0, 0); PG8_LDB(B1, 0, 1); PG8_SCHED; PG8_LDA(At, 0, 0); PG8_STAGE(PG8_SA(1, 1), a1 + hstepA, voffA);
            PG8_WAIT_V(8); PG8_WAIT_L(0); PG8_BAR; PG8_MMA(0, 0, At, B0); PG8_MMA(0, 1, At, B1); PG8_BAR; PG8_SCHED;
            PG8_LDA(At, 0, 1); PG8_STAGE(PG8_SB(0, 0), b2, voffB); PG8_STAGE(PG8_SB(0, 1), b2 + hstepB, voffB); PG8_STAGE(PG8_SA(0, 0), a2, voffA);
            PG8_WAIT_V(8); PG8_WAIT_L(0); PG8_BAR; PG8_MMA(1, 0, At, B0); PG8_MMA(1, 1, At, B1); PG8_BAR; PG8_SCHED;
            PG8_LDB(B0, 1, 0); PG8_LDB(B1, 1, 1); PG8_SCHED; PG8_LDA(At, 1, 0); PG8_STAGE(PG8_SA(0, 1), a2 + hstepA, voffA);
            PG8_WAIT_V(8); PG8_WAIT_L(0); PG8_BAR; PG8_MMA(0, 0, At, B0); PG8_MMA(0, 1, At, B1); PG8_BAR; PG8_SCHED;
            PG8_LDA(At, 1, 1); PG8_STAGE(PG8_SB(1, 0), b3, voffB); PG8_STAGE(PG8_SB(1, 1), b3 + hstepB, voffB); PG8_STAGE(PG8_SA(1, 0), a3, voffA);
            PG8_WAIT_V(8); PG8_WAIT_L(0); PG8_BAR; PG8_MMA(1, 0, At, B0); PG8_MMA(1, 1, At, B1); PG8_BAR; PG8_SCHED;
        }
        if (wr == 0) PG8_BAR;
        E(acc, cur, wr, wc, fr, fq);
        if (!has_next) break;
        if (!(Sched::CHAIN && nxt.aux != 0)) {
#pragma unroll
        for (int a = 0; a < 2; ++a)
#pragma unroll
            for (int b = 0; b < 2; ++b)
#pragma unroll
                for (int m = 0; m < 4; ++m)
#pragma unroll
                    for (int n = 0; n < 2; ++n) acc[a][b][m][n] = (f32x4){0.f, 0.f, 0.f, 0.f};
        }
        cur = nxt; cA = nA; cB = nB; ++ui;
        if (wr == 1) PG8_BAR;
    }
    PG8_WAIT_V(0);
    PG8_BAR;
#undef PG8_SA
#undef PG8_SB
#undef PG8_STAGE
#undef PG8_LDA
#undef PG8_LDB
#undef PG8_MMA
#undef PG8_WAIT_V
#undef PG8_WAIT_L
#undef PG8_BAR
#undef PG8_SCHED
}
}
using pg8::Unit;

#define EPI_ARGS f32x4 (&acc)[2][2][4][2], const Unit& u, int wr, int wc, int fr, int fq
struct EpiInProj {
    bf16* P; LAS const float* qg; LAS const float* kg; LAS const float* ropec; LAS const float* ropes;
    __device__ __forceinline__ void operator()(EPI_ARGS) const {
        const int slot = 4 * u.pn + wc;
        const bool is_q = slot < 8 || (slot >= 12 && slot < 20);
        const bool do_norm = slot < 10;
        const bool do_rope = (slot < 10 || (slot >= 12 && slot < 28)) && (u.pm % 17 != 0);
        LAS const float* g = slot < 8 ? qg : kg;
        const float qs = is_q ? C2 : 1.f;
#pragma unroll
        for (int ai = 0; ai < 2; ++ai)
#pragma unroll
            for (int m = 0; m < 4; ++m) {
                const int r = u.pm * 256 + ai * 128 + wr * 64 + m * 16 + fr;
                f32x4 v[2][2];
#pragma unroll
                for (int bj = 0; bj < 2; ++bj)
#pragma unroll
                    for (int n = 0; n < 2; ++n) v[bj][n] = acc[ai][bj][m][n];
                if (do_norm) {
                    float ss = 0.f;
#pragma unroll
                    for (int bj = 0; bj < 2; ++bj)
#pragma unroll
                        for (int n = 0; n < 2; ++n) ss += (v[bj][n][0] * v[bj][n][0] + v[bj][n][1] * v[bj][n][1]) + (v[bj][n][2] * v[bj][n][2] + v[bj][n][3] * v[bj][n][3]);
                    { auto r16_ = __builtin_amdgcn_permlane16_swap(__float_as_uint(ss), __float_as_uint(ss), false, false); ss = __uint_as_float(r16_[0]) + __uint_as_float(r16_[1]); }
                    { auto r32_ = __builtin_amdgcn_permlane32_swap(__float_as_uint(ss), __float_as_uint(ss), false, false); ss = __uint_as_float(r32_[0]) + __uint_as_float(r32_[1]); }
                    const float rstd = __builtin_amdgcn_rsqf(ss * (1.f / 64.f) + EPS);
#pragma unroll
                    for (int bj = 0; bj < 2; ++bj)
#pragma unroll
                        for (int n = 0; n < 2; ++n) v[bj][n] = v[bj][n] * rstd * *(LAS const f32x4*)(g + 32 * bj + 16 * n + 4 * fq);
                }
                if (do_rope) {
                    const int t = (r % SEQ) - NCTX;
#pragma unroll
                    for (int bj = 0; bj < 2; ++bj) {
                        const int p = bj == 0 ? (t >> 6) : (t & 63);
                        const f32x4 cs = *(LAS const f32x4*)(ropec + p * 16 + 4 * fq), sn = *(LAS const f32x4*)(ropes + p * 16 + 4 * fq);
                        const f32x4 x1 = v[bj][0], x2 = v[bj][1];
                        v[bj][0] = x1 * cs - x2 * sn; v[bj][1] = x2 * cs + x1 * sn;
                    }
                }
                bf16* rowp = P + (size_t)r * NP + 64 * slot + 16 * (fq & 1) + 8 * (fq >> 1);
#pragma unroll
                for (int bj = 0; bj < 2; ++bj) { const f32x4 o0 = v[bj][0] * qs, o1 = v[bj][1] * qs;
                    const auto rx = __builtin_amdgcn_permlane16_swap(cvtpk(o0[0], o0[1]), cvtpk(o1[0], o1[1]), false, false);
                    const auto ry = __builtin_amdgcn_permlane16_swap(cvtpk(o0[2], o0[3]), cvtpk(o1[2], o1[3]), false, false);
                    *(u32x4*)(rowp + 32 * bj) = (u32x4){rx[0], ry[0], rx[1], ry[1]}; }
                asm volatile("" ::: "memory");
            }
    }
};
struct EpiSigmoid {
    bf16* O; int ldc;
    __device__ __forceinline__ void operator()(EPI_ARGS) const {
        bf16* tp = O + ((size_t)(u.pm * 12 + u.pn) << 16) + (size_t)((wr * 4 + wc) * 8192 + (fq * 16 + fr) * 8);
#pragma unroll
        for (int ai = 0; ai < 2; ++ai)
#pragma unroll
            for (int m = 0; m < 4; ++m)
#pragma unroll
                for (int bj = 0; bj < 2; ++bj) { const f32x4 v0 = acc[ai][bj][m][0], v1 = acc[ai][bj][m][1];
                    *(u32x4*)(tp + ((ai * 4 + m) * 2 + bj) * 512) = (u32x4){cvtpk(invsigmoidf_(v0[0]), invsigmoidf_(v0[1])), cvtpk(invsigmoidf_(v0[2]), invsigmoidf_(v0[3])), cvtpk(invsigmoidf_(v1[0]), invsigmoidf_(v1[1])), cvtpk(invsigmoidf_(v1[2]), invsigmoidf_(v1[3]))}; }
    }
};
struct EpiMerge {
    const bf16* G; bf16* U;
    __device__ __forceinline__ void operator()(EPI_ARGS) const {
        const int row0 = u.pm * 256 + wr * 64 + fr, col0 = u.pn * 256 + wc * 64 + fq * 16; const int br = u.aux;
        const bf16* gb = G + ((size_t)(u.pm * 12 + br * 4 + u.pn) << 16) + (size_t)((wr * 4 + wc) * 8192 + (fq * 16 + fr) * 8);
#pragma unroll
        for (int ai = 0; ai < 2; ++ai) {
            u32x4 gw[4][2], hw[4][2];
#pragma unroll
            for (int m = 0; m < 4; ++m)
#pragma unroll
                for (int bj = 0; bj < 2; ++bj) { const bf16* gp = gb + ((ai * 4 + m) * 2 + bj) * 512; gw[m][bj] = *(const u32x4*)gp; if (br != 2) hw[m][bj] = *(const u32x4*)(gp + 4 * 65536); }
#pragma unroll
            for (int m = 0; m < 4; ++m)
#pragma unroll
                for (int bj = 0; bj < 2; ++bj) {
                    const u32x4 g4 = gw[m][bj];
                    float s[8] = {bflo(g4.x), bfhi(g4.x), bflo(g4.y), bfhi(g4.y), bflo(g4.z), bfhi(g4.z), bflo(g4.w), bfhi(g4.w)};
#pragma unroll
                    for (int i = 0; i < 8; ++i) s[i] = __builtin_amdgcn_rcpf(s[i]);
                    if (br != 2) {
                        const u32x4 h4 = hw[m][bj];
                        const float d[8] = {bflo(h4.x), bfhi(h4.x), bflo(h4.y), bfhi(h4.y), bflo(h4.z), bfhi(h4.z), bflo(h4.w), bfhi(h4.w)};
#pragma unroll
                        for (int i = 0; i < 8; ++i) s[i] *= d[i];
                    }
                    f32x4& v0 = acc[ai][bj][m][0]; f32x4& v1 = acc[ai][bj][m][1];
                    v0[0] *= s[0]; v0[1] *= s[1]; v0[2] *= s[2]; v0[3] *= s[3]; v1[0] *= s[4]; v1[1] *= s[5]; v1[2] *= s[6]; v1[3] *= s[7];
                    if (br == 2) *(u32x4*)(U + (size_t)(row0 + ai * 128 + m * 16) * 1024 + col0 + bj * 8) = (u32x4){cvtpk(v0[0], v0[1]), cvtpk(v0[2], v0[3]), cvtpk(v1[0], v1[1]), cvtpk(v1[2], v1[3])}; }
        }
    }
};
struct EpiF32 {
    float* C; int ldc;
    __device__ __forceinline__ void operator()(EPI_ARGS) const {
        const int row0 = u.pm * 256 + wr * 64 + fr, col0 = u.pn * 256 + wc * 32 + 4 * fq;
#pragma unroll
        for (int ai = 0; ai < 2; ++ai)
#pragma unroll
            for (int m = 0; m < 4; ++m) { float* rowp = C + (size_t)(row0 + ai * 128 + m * 16) * ldc + col0;
#pragma unroll
                for (int bj = 0; bj < 2; ++bj)
#pragma unroll
                    for (int n = 0; n < 2; ++n) *(f32x4*)(rowp + bj * 128 + n * 16) = acc[ai][bj][m][n]; }
    }
};
struct EpiBf16 {
    bf16* O; int ldc;
    __device__ __forceinline__ void operator()(EPI_ARGS) const {
        const int row0 = u.pm * 256 + wr * 64 + fr, col0 = u.pn * 256 + wc * 32 + 16 * (fq & 1) + 8 * (fq >> 1);
#pragma unroll
        for (int ai = 0; ai < 2; ++ai)
#pragma unroll
            for (int m = 0; m < 4; ++m) { bf16* rowp = O + (size_t)(row0 + ai * 128 + m * 16) * ldc + col0;
#pragma unroll
                for (int bj = 0; bj < 2; ++bj) { const f32x4 v0 = acc[ai][bj][m][0], v1 = acc[ai][bj][m][1];
                    const auto rx = __builtin_amdgcn_permlane16_swap(cvtpk(v0[0], v0[1]), cvtpk(v1[0], v1[1]), false, false);
                    const auto ry = __builtin_amdgcn_permlane16_swap(cvtpk(v0[2], v0[3]), cvtpk(v1[2], v1[3]), false, false);
                    *(u32x4*)(rowp + bj * 128) = (u32x4){rx[0], ry[0], rx[1], ry[1]}; } }
    }
};
struct EpiSwiGLU {
    bf16* H; int ldc;
    __device__ __forceinline__ void operator()(EPI_ARGS) const {
        const int row0 = u.pm * 256 + wr * 64 + fr, col0 = u.pn * 128 + wc * 32 + 16 * (fq & 1) + 8 * (fq >> 1);
#pragma unroll
        for (int ai = 0; ai < 2; ++ai)
#pragma unroll
            for (int m = 0; m < 4; ++m) { bf16* rowp = H + (size_t)(row0 + ai * 128 + m * 16) * ldc + col0;
                const f32x4 g0 = acc[ai][0][m][0], u0 = acc[ai][1][m][0], g1 = acc[ai][0][m][1], u1 = acc[ai][1][m][1];
                const auto rx = __builtin_amdgcn_permlane16_swap(cvtpk(siluf_(g0[0]) * u0[0], siluf_(g0[1]) * u0[1]), cvtpk(siluf_(g1[0]) * u1[0], siluf_(g1[1]) * u1[1]), false, false);
                const auto ry = __builtin_amdgcn_permlane16_swap(cvtpk(siluf_(g0[2]) * u0[2], siluf_(g0[3]) * u0[3]), cvtpk(siluf_(g1[2]) * u1[2], siluf_(g1[3]) * u1[3]), false, false);
                *(u32x4*)rowp = (u32x4){rx[0], ry[0], rx[1], ry[1]}; }
    }
};
struct EpiMoeDown {
    bf16* YS; const int* rowslot; const float* roww;
    __device__ __forceinline__ void operator()(EPI_ARGS) const {
        const int row0 = u.pm * 256 + wr * 64 + fr, col0 = u.pn * 256 + wc * 32 + 16 * (fq & 1) + 8 * (fq >> 1);
#pragma unroll
        for (int ai = 0; ai < 2; ++ai)
#pragma unroll
            for (int m = 0; m < 4; ++m) { const int r = row0 + ai * 128 + m * 16; int slot = rowslot[r]; if ((unsigned)slot >= 2u * NB * TLAT) slot = -1; const float w = roww[r];
                bf16* rowp = YS + (size_t)(slot < 0 ? 0 : slot) * 1024 + col0;
#pragma unroll
                for (int bj = 0; bj < 2; ++bj) { const f32x4 v0 = acc[ai][bj][m][0] * w, v1 = acc[ai][bj][m][1] * w;
                    const auto rx = __builtin_amdgcn_permlane16_swap(cvtpk(v0[0], v0[1]), cvtpk(v1[0], v1[1]), false, false);
                    const auto ry = __builtin_amdgcn_permlane16_swap(cvtpk(v0[2], v0[3]), cvtpk(v1[2], v1[3]), false, false);
                    if (slot >= 0) *(u32x4*)(rowp + bj * 128) = (u32x4){rx[0], ry[0], rx[1], ry[1]}; }
                asm volatile("" ::: "memory"); }
    }
};

struct InProjOrder {
    static constexpr bool CHAIN = false;
    int G, c, skip; const char* A; const char* B;
    __device__ __forceinline__ bool next(int i, Unit& u) const {
        const int L = i * G + c;
        if (L < 128 * 17) { pg8::tile_of(L, 128, 17, u.pm, u.pn); u.pm += (u.pm >> 4) + 1; }
        else { const int j = L - 128 * 17; int b, k;
            if (skip) { if (j >= 72) return false; b = j / 9; k = j - 9 * b; k += 2 + (k > 0 ? 2 : 0) + (k > 4 ? 2 : 0); } else { if (j >= 136) return false; b = j / 17; k = j - 17 * b; }
            u.pm = 17 * b; u.pn = k; }
        u.aux = 0; u.a = A + (size_t)u.pm * (256 * D * 2); u.b = B + (size_t)u.pn * (256 * D * 2); return true;
    }
};
struct MergeOrder {
    static constexpr bool CHAIN = true;
    int nM, nN, nwg, G, c, lat; const char *A0, *B0;
    __device__ __forceinline__ bool next(int i, Unit& u) const {
        const int ti = i / 3, br = i - 3 * ti; const long L = (long)ti * G + c; if (L >= nwg) return false;
        pg8::tile_of((int)L, nM, nN, u.pm, u.pn); if (lat) u.pm += (u.pm >> 4) + 1; u.aux = br;
        const char* a = A0 + (size_t)br * (34 * MiB); const char* b = B0 + (size_t)br * (1 * MiB);
        u.a = a + (size_t)u.pm * (256 * 512 * 2); u.b = b + (size_t)u.pn * (256 * 512 * 2); return true;
    }
};
struct MoeOrder {
    static constexpr bool CHAIN = false;
    int tb[NEXP + 1]; int nN, G, c; const char* A; const char* B; size_t ta, tb_tile, tb_exp;
    __device__ __forceinline__ bool next(int i, Unit& u) const {
        const long L = (long)i * G + c; const int nwg = tb[NEXP] * nN; if (L >= nwg) return false;
        const int rt = (int)L / nN, pn = (int)L % nN; int e = 0;
#pragma unroll
        for (int j = 1; j < NEXP; ++j) e += (rt >= tb[j]) ? 1 : 0;
        u.pm = rt; u.pn = pn; u.aux = e; u.a = A + (size_t)rt * ta; u.b = B + (size_t)e * tb_exp + (size_t)pn * tb_tile; return true;
    }
};

constexpr int AT_KP = 72;
constexpr int AT_KBYTES = 64 * AT_KP * 2;
typedef short v4i16_t __attribute__((ext_vector_type(4)));
template <int DV>
__device__ __forceinline__ void attn_pass(const bf16* qrow, const bf16* kbase, const bf16* vbase, int NT, LAS unsigned char* lds, f32x16 (&o)[DV / 32]) {
    constexpr int DB = DV / 32, VRB = DV * 2  , AT_BUF = 8192 + 64 * VRB, NVP = DV / 64  ;
    int tid_ = threadIdx.x; asm volatile("" : "+v"(tid_));
    const int tid = tid_, lane = tid & 63, wid = __builtin_amdgcn_readfirstlane(tid >> 6), r32 = lane & 31, hi = lane >> 5;
    bf16x8 qf[4];
#pragma unroll
    for (int ds = 0; ds < 4; ++ds) qf[ds] = *(const bf16x8*)(qrow + 16 * ds + 8 * hi);
    LAS unsigned char* qlds = lds + 4 * AT_BUF + wid * 4096;
    if (DV == 128) {
#pragma unroll
        for (int ds = 0; ds < 4; ++ds) *(LAS bf16x8*)(qlds + r32 * 128 + (((2 * ds + hi) ^ ((r32 >> 1) & 7)) * 16)) = qf[ds];
    }
#define AT_QF(ds) (DV == 64 ? qf[ds] : *(const LAS bf16x8*)(qlo_ + kr_off[ds]))
#pragma unroll
    for (int db = 0; db < DB; ++db)
#pragma unroll
        for (int r = 0; r < 16; ++r) o[db][r] = 0.f;
    f32x16 negm; const f32x16 zero16 = {0.f, 0.f, 0.f, 0.f, 0.f, 0.f, 0.f, 0.f, 0.f, 0.f, 0.f, 0.f, 0.f, 0.f, 0.f, 0.f};
#pragma unroll
    for (int r = 0; r < 16; ++r) negm[r] = 0.f;
    if (DV == 64) asm volatile("" : "+v"(negm));
    float mhat = 0.f, lsum = 0.f;
    const int drow = 8 * wid + (lane >> 3), dslot = lane & 7;
    const bf16* kptr = kbase + (size_t)drow * NP + 8 * (dslot ^ ((drow >> 1) & 7));
    const int vrow = (DV == 64) ? drow : 4 * wid + (lane >> 4);
    const int vchk = (DV == 64) ? (dslot ^ (4 * ((drow >> 1) & 1))) : ((lane & 15) ^ (4 * (vrow & 3)));
    const bf16* vptr = vbase + (size_t)vrow * NP + 8 * vchk;
    const unsigned dk_off = (unsigned)wid * 1024u, dv_off = 8192u + (unsigned)wid * 1024u, lds0 = (unsigned)(uintptr_t)lds;
    int kr_off[4];
#pragma unroll
    for (int ds = 0; ds < 4; ++ds) kr_off[ds] = r32 * 128 + (((2 * ds + hi) ^ ((r32 >> 1) & 7)) * 16);
    const int q4 = (lane & 15) >> 2, p4 = lane & 3, g1 = (lane >> 4) & 1;
    int vt_off[DB];
#pragma unroll
    for (int db = 0; db < DB; ++db) vt_off[db] = 8192 + (4 * hi + q4) * VRB + ((DV == 64 ? (db ^ (q4 >> 1)) : (db ^ q4)) * 64) + (2 * g1 + (p4 >> 1)) * 16 + 8 * (p4 & 1);
#define AT_GLDS(gsrc, ldsaddr) do { unsigned keep_; asm volatile("s_mov_b32 %0, m0\n\ts_mov_b32 m0, %2\n\ts_nop 0\n\tglobal_load_lds_dwordx4 %1, off\n\ts_mov_b32 m0, %0" : "=&s"(keep_) : "v"(gsrc), "s"(ldsaddr) : "memory"); } while (0)
#define AT_DMA(J) do { \
        AT_GLDS(kptr, (unsigned)__builtin_amdgcn_readfirstlane(lds0 + (J) * AT_BUF + dk_off)); \
        AT_GLDS(vptr, (unsigned)__builtin_amdgcn_readfirstlane(lds0 + (J) * AT_BUF + dv_off)); \
        if (NVP == 2) AT_GLDS(vptr + (size_t)32 * NP, (unsigned)__builtin_amdgcn_readfirstlane(lds0 + (J) * AT_BUF + dv_off + 8192u)); \
        kptr += (size_t)64 * NP; vptr += (size_t)64 * NP; } while (0)
#define AT_VTR(p) __builtin_amdgcn_ds_read_tr16_b64_v4i16((LAS v4i16_t*)(p))
#define AT_QK(PN, KB, BLK) do { LAS unsigned char* qlo_ = qlds; asm volatile("" : "+v"(qlo_)); _Pragma("unroll") for (int ds = 0; ds < 4; ++ds) { \
            const bf16x8 kf = *(const LAS bf16x8*)((KB) + kr_off[ds] + 4096 * (BLK)); \
            PN = __builtin_amdgcn_mfma_f32_32x32x16_bf16(kf, AT_QF(ds), ds == 0 ? (DV == 64 ? negm : zero16) : PN, 0, 0, 0); } } while (0)
#define AT_VRD(VL, VH, KS, VBP, BLKP) do { _Pragma("unroll") for (int db = 0; db < DB; ++db) { \
            VL[db] = AT_VTR((VBP) + vt_off[db] + (32 * (BLKP) + 16 * (KS)) * VRB); VH[db] = AT_VTR((VBP) + vt_off[db] + (32 * (BLKP) + 16 * (KS) + 8) * VRB); } } while (0)
#define AT_VF(VL, VH, db) ((bf16x8){VL[db][0], VL[db][1], VL[db][2], VL[db][3], VH[db][0], VH[db][1], VH[db][2], VH[db][3]})
#define AT_PVM(VL, VH, PF, db) o[db] = __builtin_amdgcn_mfma_f32_32x32x16_bf16(AT_VF(VL, VH, db), PF, o[db], 0, 0, 0)
#define AT_QKM(PN, ds) PN = __builtin_amdgcn_mfma_f32_32x32x16_bf16(kf_[ds], AT_QF(ds), (ds) == 0 ? (DV == 64 ? negm : zero16) : PN, 0, 0, 0)
#define AT_EXPS(PC) do { float rs_ = 0.f; \
        _Pragma("unroll") for (int r = 0; r < 16; ++r) { const float e_ = __builtin_amdgcn_exp2f(DV == 64 ? PC[r] : PC[r] - mhat); PC[r] = e_; rs_ += e_; } \
        lsum += rs_; \
        np0_.x = cvtpk(PC[0], PC[1]); np0_.y = cvtpk(PC[2], PC[3]); np0_.z = cvtpk(PC[4], PC[5]); np0_.w = cvtpk(PC[6], PC[7]); \
        np1_.x = cvtpk(PC[8], PC[9]); np1_.y = cvtpk(PC[10], PC[11]); np1_.z = cvtpk(PC[12], PC[13]); np1_.w = cvtpk(PC[14], PC[15]); } while (0)
#define AT_SCALE_PK(W, F) do { W.x = cvtpk(bflo(W.x) * (F), bfhi(W.x) * (F)); W.y = cvtpk(bflo(W.y) * (F), bfhi(W.y) * (F)); W.z = cvtpk(bflo(W.z) * (F), bfhi(W.z) * (F)); W.w = cvtpk(bflo(W.w) * (F), bfhi(W.w) * (F)); } while (0)
#define AT_STEP_OLD(PC, PN, DO_QK, KB, NBLK, HAVE_PREV, VBP, BLKP, FIRST) do { \
        bf16x8 kf_[4]; LAS unsigned char* qlo_ = qlds; asm volatile("" : "+v"(qlo_)); \
        if (DV == 64 && (DO_QK)) { _Pragma("unroll") for (int ds = 0; ds < 4; ++ds) kf_[ds] = *(const LAS bf16x8*)((KB) + kr_off[ds] + 4096 * (NBLK)); } \
        if (HAVE_PREV) { _Pragma("unroll") for (int ks = 0; ks < 2; ++ks) { v4i16_t vl_[DB], vh_[DB]; \
            _Pragma("unroll") for (int db = 0; db < DB; ++db) { \
                vl_[db] = AT_VTR((VBP) + vt_off[db] + (32 * (BLKP) + 16 * ks) * VRB); vh_[db] = AT_VTR((VBP) + vt_off[db] + (32 * (BLKP) + 16 * ks + 8) * VRB); } \
            const bf16x8 pf_ = __builtin_bit_cast(bf16x8, ks == 0 ? pwp0 : pwp1); \
            _Pragma("unroll") for (int db = 0; db < DB; ++db) { \
                const bf16x8 vf_ = (bf16x8){vl_[db][0], vl_[db][1], vl_[db][2], vl_[db][3], vh_[db][0], vh_[db][1], vh_[db][2], vh_[db][3]}; \
                o[db] = __builtin_amdgcn_mfma_f32_32x32x16_bf16(vf_, pf_, o[db], 0, 0, 0); } \
            if (DV == 128) __builtin_amdgcn_sched_barrier(0); } } \
        if (DV == 128 && (DO_QK)) { _Pragma("unroll") for (int ds = 0; ds < 4; ++ds) kf_[ds] = *(const LAS bf16x8*)((KB) + kr_off[ds] + 4096 * (NBLK)); } \
        __builtin_amdgcn_sched_barrier(0); \
        float a_ = __builtin_fmaxf(__builtin_fmaxf(PC[0], PC[1]), PC[2]), b_ = __builtin_fmaxf(__builtin_fmaxf(PC[3], PC[4]), PC[5]); \
        a_ = __builtin_fmaxf(__builtin_fmaxf(a_, PC[6]), PC[7]); b_ = __builtin_fmaxf(__builtin_fmaxf(b_, PC[8]), PC[9]); \
        a_ = __builtin_fmaxf(__builtin_fmaxf(a_, PC[10]), PC[11]); b_ = __builtin_fmaxf(__builtin_fmaxf(b_, PC[12]), PC[13]); \
        a_ = __builtin_fmaxf(__builtin_fmaxf(a_, PC[14]), PC[15]); \
        float rm_ = __builtin_fmaxf(a_, b_); \
        { auto rr_ = __builtin_amdgcn_permlane32_swap(__float_as_uint(rm_), __float_as_uint(rm_), false, false); rm_ = __builtin_fmaxf(__uint_as_float(rr_[0]), __uint_as_float(rr_[1])); } \
        if (DV == 128) rm_ -= mhat; \
        if ((FIRST) || __any(rm_ > 8.f)) { const float dl_ = (FIRST) ? rm_ : __builtin_fmaxf(rm_, 0.f); mhat += dl_; \
            if (DV == 64) { _Pragma("unroll") for (int r = 0; r < 16; ++r) PC[r] -= dl_; \
                _Pragma("unroll") for (int r = 0; r < 16; ++r) negm[r] = -mhat; asm volatile("" : "+v"(negm)); } \
            const float f_ = __builtin_amdgcn_exp2f(-dl_); lsum *= f_; \
            _Pragma("unroll") for (int db = 0; db < DB; ++db) _Pragma("unroll") for (int r = 0; r < 16; ++r) o[db][r] *= f_; } \
        __builtin_amdgcn_sched_barrier(0); \
        if (DO_QK) { _Pragma("unroll") for (int ds = 0; ds < 4; ++ds) PN = __builtin_amdgcn_mfma_f32_32x32x16_bf16(kf_[ds], AT_QF(ds), ds == 0 ? (DV == 64 ? negm : zero16) : PN, 0, 0, 0); } \
        { float rs_ = 0.f; \
          _Pragma("unroll") for (int r = 0; r < 16; ++r) { const float e_ = __builtin_amdgcn_exp2f(DV == 64 ? PC[r] : PC[r] - mhat); PC[r] = e_; rs_ += e_; } \
          lsum += rs_; } \
        pwp0.x = cvtpk(PC[0], PC[1]); pwp0.y = cvtpk(PC[2], PC[3]); pwp0.z = cvtpk(PC[4], PC[5]); pwp0.w = cvtpk(PC[6], PC[7]); \
        pwp1.x = cvtpk(PC[8], PC[9]); pwp1.y = cvtpk(PC[10], PC[11]); pwp1.z = cvtpk(PC[12], PC[13]); pwp1.w = cvtpk(PC[14], PC[15]); \
        if (DO_QK) { __builtin_amdgcn_sched_group_barrier(0x002, 6, 0); \
            _Pragma("unroll") for (int i_ = 0; i_ < 4; ++i_) { __builtin_amdgcn_sched_group_barrier(0x008, 1, 0); __builtin_amdgcn_sched_group_barrier(0x002, 9, 0); } } \
        __builtin_amdgcn_sched_barrier(0); } while (0)
#define AT_STEP_NEW(PC, PN, DO_QK, KB, NBLK, HAVE_PREV, VBP, BLKP, FIRST) do { \
        bf16x8 kf_[4]; v4i16_t vl0_[DB], vh0_[DB], vl1_[DB], vh1_[DB]; u32x4 np0_, np1_; LAS unsigned char* qlo_ = qlds; asm volatile("" : "+v"(qlo_)); \
        if (DO_QK) { _Pragma("unroll") for (int ds = 0; ds < (DV == 64 ? 4 : 2); ++ds) kf_[ds] = *(const LAS bf16x8*)((KB) + kr_off[ds] + 4096 * (NBLK)); } \
        if (HAVE_PREV) { AT_VRD(vl0_, vh0_, 0, VBP, BLKP); if (DV == 64) AT_VRD(vl1_, vh1_, 1, VBP, BLKP); } \
        __builtin_amdgcn_sched_barrier(0); \
        float a_ = __builtin_fmaxf(__builtin_fmaxf(PC[0], PC[1]), PC[2]), b_ = __builtin_fmaxf(__builtin_fmaxf(PC[3], PC[4]), PC[5]); \
        a_ = __builtin_fmaxf(__builtin_fmaxf(a_, PC[6]), PC[7]); b_ = __builtin_fmaxf(__builtin_fmaxf(b_, PC[8]), PC[9]); \
        a_ = __builtin_fmaxf(__builtin_fmaxf(a_, PC[10]), PC[11]); b_ = __builtin_fmaxf(__builtin_fmaxf(b_, PC[12]), PC[13]); \
        a_ = __builtin_fmaxf(__builtin_fmaxf(a_, PC[14]), PC[15]); \
        float rm_ = __builtin_fmaxf(a_, b_); \
        { auto rr_ = __builtin_amdgcn_permlane32_swap(__float_as_uint(rm_), __float_as_uint(rm_), false, false); rm_ = __builtin_fmaxf(__uint_as_float(rr_[0]), __uint_as_float(rr_[1])); } \
        if (DV == 128) rm_ -= mhat; \
        if ((FIRST) || __any(rm_ > 8.f)) {     \
            const float dl_ = (FIRST) ? rm_ : __builtin_fmaxf(rm_, 0.f); mhat += dl_; \
            if (DV == 64) { _Pragma("unroll") for (int r = 0; r < 16; ++r) PC[r] -= dl_; \
                _Pragma("unroll") for (int r = 0; r < 16; ++r) negm[r] = -mhat; asm volatile("" : "+v"(negm)); } \
            const float f_ = __builtin_amdgcn_exp2f(-dl_); lsum *= f_; \
            _Pragma("unroll") for (int db = 0; db < DB; ++db) _Pragma("unroll") for (int r = 0; r < 16; ++r) o[db][r] *= f_; \
            if (HAVE_PREV) { AT_SCALE_PK(pwp0, f_); AT_SCALE_PK(pwp1, f_); } } \
        __builtin_amdgcn_sched_barrier(0); \
        const bf16x8 pf0_ = __builtin_bit_cast(bf16x8, pwp0), pf1_ = __builtin_bit_cast(bf16x8, pwp1); \
        if (DV == 64) { \
            if (DO_QK) AT_QKM(PN, 0); if (HAVE_PREV) AT_PVM(vl0_, vh0_, pf0_, 0); \
            if (DO_QK) AT_QKM(PN, 1); if (HAVE_PREV) AT_PVM(vl0_, vh0_, pf0_, 1); \
            if (DO_QK) AT_QKM(PN, 2); if (HAVE_PREV) AT_PVM(vl1_, vh1_, pf1_, 0); \
            if (DO_QK) AT_QKM(PN, 3); if (HAVE_PREV) AT_PVM(vl1_, vh1_, pf1_, 1); \
            AT_EXPS(PC); \
            if ((DO_QK) && (HAVE_PREV)) { _Pragma("unroll") for (int i_ = 0; i_ < 8; ++i_) { __builtin_amdgcn_sched_group_barrier(0x008, 1, 0); __builtin_amdgcn_sched_group_barrier(0x002, 5, 0); } } \
        } else { \
            if (DO_QK) AT_QKM(PN, 0); if (HAVE_PREV) { AT_PVM(vl0_, vh0_, pf0_, 0); AT_PVM(vl0_, vh0_, pf0_, 1); } \
            if (DO_QK) { AT_QKM(PN, 1); _Pragma("unroll") for (int ds = 2; ds < 4; ++ds) kf_[ds] = *(const LAS bf16x8*)((KB) + kr_off[ds] + 4096 * (NBLK)); } \
            if (HAVE_PREV) { AT_PVM(vl0_, vh0_, pf0_, 2); AT_PVM(vl0_, vh0_, pf0_, 3); AT_VRD(vl1_, vh1_, 1, VBP, BLKP); } \
            if (DO_QK) AT_QKM(PN, 2); if (HAVE_PREV) { AT_PVM(vl1_, vh1_, pf1_, 0); AT_PVM(vl1_, vh1_, pf1_, 1); } \
            if (DO_QK) AT_QKM(PN, 3); if (HAVE_PREV) { AT_PVM(vl1_, vh1_, pf1_, 2); AT_PVM(vl1_, vh1_, pf1_, 3); } \
            AT_EXPS(PC); \
        } \
        pwp0 = np0_; pwp1 = np1_; \
        __builtin_amdgcn_sched_barrier(0); } while (0)
#define AT_STEP(PC, PN, DO_QK, KB, NBLK, HAVE_PREV, VBP, BLKP, FIRST) do { if constexpr (DV == 64) AT_STEP_NEW(PC, PN, DO_QK, KB, NBLK, HAVE_PREV, VBP, BLKP, FIRST); else AT_STEP_OLD(PC, PN, DO_QK, KB, NBLK, HAVE_PREV, VBP, BLKP, FIRST); } while (0)
    f32x16 pa, pb; u32x4 pwp0, pwp1;
    AT_DMA(0); AT_DMA(1); AT_DMA(2);
    if (NVP == 2) asm volatile("s_waitcnt vmcnt(6)" ::: "memory"); else asm volatile("s_waitcnt vmcnt(4)" ::: "memory");
    __builtin_amdgcn_s_barrier(); asm volatile("" ::: "memory");
    AT_QK(pa, lds, 0);
#define AT_TILE(J, FIRST) do { const int t = t0 + (J); \
        if (FIRST) AT_STEP(pa, pb, true, lds + (J) * AT_BUF, 1, false, lds, 0, true); \
        else AT_STEP(pa, pb, true, lds + (J) * AT_BUF, 1, true, lds + (((J) + 3) & 3) * AT_BUF, 1, false); \
        if (t + 2 < NT) { if (NVP == 2) asm volatile("s_waitcnt vmcnt(3)" ::: "memory"); else asm volatile("s_waitcnt vmcnt(2)" ::: "memory"); } else asm volatile("s_waitcnt vmcnt(0)" ::: "memory"); \
        asm volatile("s_waitcnt lgkmcnt(0)" ::: "memory"); \
        __builtin_amdgcn_s_barrier(); asm volatile("" ::: "memory"); \
        if (t + 3 < NT) AT_DMA(((J) + 3) & 3); \
        if (t + 1 < NT) AT_STEP(pb, pa, true, lds + (((J) + 1) & 3) * AT_BUF, 0, true, lds + (J) * AT_BUF, 0, false); \
        else AT_STEP(pb, pa, false, lds + (((J) + 1) & 3) * AT_BUF, 0, true, lds + (J) * AT_BUF, 0, false); } while (0)
    for (int t0 = 0; t0 < NT; t0 += 4) {
        if (t0 == 0) AT_TILE(0, true); else AT_TILE(0, false);
        AT_TILE(1, false); AT_TILE(2, false); AT_TILE(3, false);
    }
#undef AT_TILE
    {
        _Pragma("unroll") for (int ks = 0; ks < 2; ++ks) { const bf16x8 pf_ = __builtin_bit_cast(bf16x8, ks == 0 ? pwp0 : pwp1);
            _Pragma("unroll") for (int db = 0; db < DB; ++db) {
                const v4i16_t lo_ = AT_VTR(lds + 3 * AT_BUF + vt_off[db] + (32 + 16 * ks) * VRB), hi_ = AT_VTR(lds + 3 * AT_BUF + vt_off[db] + (32 + 16 * ks + 8) * VRB);
                const bf16x8 vf_ = (bf16x8){lo_[0], lo_[1], lo_[2], lo_[3], hi_[0], hi_[1], hi_[2], hi_[3]};
                o[db] = __builtin_amdgcn_mfma_f32_32x32x16_bf16(vf_, pf_, o[db], 0, 0, 0); } }
    }
#undef AT_DMA
#undef AT_QF
#undef AT_VRD
#undef AT_VF
#undef AT_PVM
#undef AT_QKM
#undef AT_EXPS
#undef AT_SCALE_PK
#undef AT_GLDS
#undef AT_VTR
#undef AT_QK
#undef AT_STEP
#undef AT_STEP_OLD
#undef AT_STEP_NEW
    lsum += __shfl_xor(lsum, 32);
    const float inv = 1.f / lsum;
#pragma unroll
    for (int db = 0; db < DB; ++db)
#pragma unroll
        for (int r = 0; r < 16; ++r) o[db][r] *= inv;
    __syncthreads();
}

__device__ __forceinline__ void attn_unit_a(const bf16* PROJ, bf16* AO, int q0, int k0, int NT, int h, LAS unsigned char* lds) {
    int tid_ = threadIdx.x; asm volatile("" : "+v"(tid_));
    const int tid = tid_, lane = tid & 63, wid = tid >> 6, r32 = lane & 31, hi = lane >> 5;
    const int qr = q0 + 32 * wid + r32, g = h >> 2;
    f32x16 o[2];
    attn_pass<64>(PROJ + (size_t)qr * NP + PA_Q + 64 * h, PROJ + (size_t)k0 * NP + PA_K + 64 * g, PROJ + (size_t)k0 * NP + PA_V + 64 * g, NT, lds, o);
    bf16* orow = AO + (size_t)qr * 512 + 64 * h + 4 * hi;
#pragma unroll
    for (int db = 0; db < 2; ++db)
#pragma unroll
        for (int rg = 0; rg < 4; ++rg) *(u32x2*)(orow + 32 * db + 8 * rg) = (u32x2){cvtpk(o[db][4 * rg], o[db][4 * rg + 1]), cvtpk(o[db][4 * rg + 2], o[db][4 * rg + 3])};
}
__device__ __forceinline__ u32x2 ld_own(const bf16* p) { const unsigned long long v = __hip_atomic_load((const unsigned long long*)p, __ATOMIC_RELAXED, __HIP_MEMORY_SCOPE_AGENT); return (u32x2){(unsigned)v, (unsigned)(v >> 32)}; }
__device__ __forceinline__ void attn_unit_b(const bf16* PROJ, bf16* BO, int q0, int k0, int NT, int hh, float lam, float oscale, const float* subg, LAS unsigned char* lds) {
    int tid_ = threadIdx.x; asm volatile("" : "+v"(tid_));
    const int tid = tid_, lane = tid & 63, wid = tid >> 6, r32 = lane & 31, hi = lane >> 5;
    const int qr = q0 + 32 * wid + r32;
    bf16* orow = BO + (size_t)qr * 512 + 128 * hh + 4 * hi;
    const bf16* qp = PROJ + (size_t)qr * NP + PB_Q + 128 * hh; const bf16* kp = PROJ + (size_t)k0 * NP + PB_K + 128 * hh; const bf16* vp = PROJ + (size_t)k0 * NP + PB_V + 128 * hh;
    f32x16 o[4];
    attn_pass<128>(qp, kp, vp, NT, lds, o);
#pragma unroll
    for (int db = 0; db < 4; ++db)
#pragma unroll
        for (int rg = 0; rg < 4; ++rg) *(u32x2*)(orow + 32 * db + 8 * rg) = (u32x2){cvtpk(o[db][4 * rg], o[db][4 * rg + 1]), cvtpk(o[db][4 * rg + 2], o[db][4 * rg + 3])};
    attn_pass<128>(qp + 64, kp + 64, vp, NT, lds, o);
    asm volatile("s_waitcnt vmcnt(0)" ::: "memory");
    float ss = 0.f;
#pragma unroll
    for (int db = 0; db < 4; ++db)
#pragma unroll
        for (int rg = 0; rg < 4; ++rg) { const u32x2 w1 = ld_own(orow + 32 * db + 8 * rg);
            const float d0 = bflo(w1.x) - lam * o[db][4 * rg], d1 = bfhi(w1.x) - lam * o[db][4 * rg + 1], d2 = bflo(w1.y) - lam * o[db][4 * rg + 2], d3 = bfhi(w1.y) - lam * o[db][4 * rg + 3];
            o[db][4 * rg] = d0; o[db][4 * rg + 1] = d1; o[db][4 * rg + 2] = d2; o[db][4 * rg + 3] = d3; ss += (d0 * d0 + d1 * d1) + (d2 * d2 + d3 * d3); }
    ss += __shfl_xor(ss, 32);
    const float rstd = oscale / sqrtf(ss * (1.f / 128.f) + EPS);
#pragma unroll
    for (int db = 0; db < 4; ++db)
#pragma unroll
        for (int rg = 0; rg < 4; ++rg) { const f32x4 gq = *(const f32x4*)(subg + 32 * db + 8 * rg + 4 * hi);
            *(u32x2*)(orow + 32 * db + 8 * rg) = (u32x2){cvtpk(o[db][4 * rg] * rstd * gq[0], o[db][4 * rg + 1] * rstd * gq[1]), cvtpk(o[db][4 * rg + 2] * rstd * gq[2], o[db][4 * rg + 3] * rstd * gq[3])}; }
}

namespace ml {
constexpr int QP = 144, SP = 80;
__device__ __forceinline__ int sw2(int row) { return (row >> 2) & 7; }
constexpr int O_QS = 0, O_KS = O_QS + 64 * QP * 2, O_KT = O_KS + 64 * QP * 2, O_VT = O_KT + 128 * SP * 2, O_VW = O_VT + 48 * SP * 2, O_PS = O_VW + 48 * SP * 2,
              O_CS = O_PS + 64 * SP * 2, CS_BYTES = 48 * QP * 2, O_SC = O_CS + 2 * CS_BYTES, SC_FLOATS = 384, O_END = O_SC + 2 * SC_FLOATS * 4;
static_assert(O_END <= RING_BYTES, "mlstm lds");
}
__device__ __forceinline__ void mlstm_unit(const bf16* CQK, bf16* PROJ, const float* GS, int b, int h, int dir, int sl, LAS unsigned char* lds) {
    using namespace ml;
    int tid_ = threadIdx.x; asm volatile("" : "+v"(tid_));
    const int tid = tid_, lane = tid & 63, wid = __builtin_amdgcn_readfirstlane(tid >> 6), fr = lane & 15, fq = lane >> 4;
    const int row0 = b * SEQ;
    const int hcol = (dir == 0 ? PC_Q : PC_K) + 128 * h + 32 * sl;
    LAS bf16* Qs = (LAS bf16*)(lds + O_QS); LAS bf16* Ks = (LAS bf16*)(lds + O_KS); LAS bf16* KT = (LAS bf16*)(lds + O_KT);
    LAS bf16* VT = (LAS bf16*)(lds + O_VT); LAS bf16* VW = (LAS bf16*)(lds + O_VW); LAS bf16* Ps = (LAS bf16*)(lds + O_PS);
    for (int i = tid; i < 48 * QP / 2; i += NTHR) ((LAS unsigned*)(lds + O_CS))[i] = 0u;
    for (int i = tid; i < 16 * SP / 2; i += NTHR) { ((LAS unsigned*)(VT + 32 * SP))[i] = (i < SP / 2) ? 0x3f803f80u : 0u; ((LAS unsigned*)(VW + 32 * SP))[i] = 0u; }
    f32x4 Cacc[3];
#pragma unroll
    for (int tm = 0; tm < 3; ++tm) Cacc[tm] = (f32x4){0.f, 0.f, 0.f, 0.f};
    float m_prev = 0.f;
    const int q_t = tid >> 3, q_c = tid & 7;
    const int kv_g = (tid >> 4) & 15, kv_c = tid & 15;
    const bool is_k = tid < 256, is_v = (tid >= 256 && tid < 320);
    const int v_g = (tid - 256) >> 2, v_c = (tid - 256) & 3;
    u32x4 qreg[2], kvreg[4];
    auto chunk_base = [&](int n) -> int { return dir == 0 ? row0 + 64 * n : (n < 4 ? row0 + 64 * (3 - n) : row0 + 64 * (71 - n)); };
    auto grow = [&](int rb, int tau) -> int { return dir == 0 ? rb + tau : rb + 63 - tau; };
    auto prefetch = [&](int n) {
        const int rb = chunk_base(n);
        const bf16* qp = CQK + (size_t)grow(rb, q_t) * 1024 + 128 * h + 16 * q_c;
        qreg[0] = *(const u32x4*)qp; qreg[1] = *(const u32x4*)(qp + 8);
        if (is_k) {
#pragma unroll
            for (int j = 0; j < 4; ++j) kvreg[j] = *(const u32x4*)(CQK + (size_t)grow(rb, 4 * kv_g + j) * 1024 + 512 + 128 * h + 8 * kv_c);
        } else if (is_v) {
#pragma unroll
            for (int j = 0; j < 4; ++j) kvreg[j] = *(const u32x4*)(PROJ + (size_t)grow(rb, 4 * v_g + j) * NP + PC_V + 128 * h + 32 * sl + 8 * v_c);
        }
    };
    const float* gsp = GS + (size_t)(((b * 4 + h) * 2 + dir) * 68) * 192 + lane;
    float gu = 0.f, gm = 0.f, ga = 0.f;
    auto gload = [&](int n) { gu = gsp[(size_t)n * 192]; gm = gsp[(size_t)n * 192 + 64]; ga = gsp[(size_t)n * 192 + 128]; };
    auto scalars = [&](int n) {
        LAS float* sc = (LAS float*)(lds + O_SC) + (n & 1) * SC_FLOATS;
        const float uu = gu, a = ga;
        const float M = fmaxf(m_prev, gm);
        const float M63 = __builtin_bit_cast(float, __builtin_amdgcn_readlane(__builtin_bit_cast(int, M), 63)), a63 = __builtin_bit_cast(float, __builtin_amdgcn_readlane(__builtin_bit_cast(int, a), 63));
        sc[lane] = uu; sc[64 + lane] = M; sc[128 + lane] = __expf(m_prev - M); sc[192 + lane] = __expf(-(a + M)); sc[256 + lane] = __expf(uu - M63);
        if (lane == 0) sc[320] = __expf(m_prev - M63);
        m_prev = a63 + M63;
        if (n + 1 < 68) gload(n + 1);
    };
    auto stage = [&](int n) {
        LAS const float* sc = (LAS const float*)(lds + O_SC) + (n & 1) * SC_FLOATS;
        *(LAS u32x4*)(Qs + q_t * QP + 16 * q_c) = qreg[0]; *(LAS u32x4*)(Qs + q_t * QP + 16 * q_c + 8) = qreg[1];
        if (is_k) {
#pragma unroll
            for (int j = 0; j < 4; ++j) *(LAS u32x4*)(Ks + (4 * kv_g + j) * QP + 8 * kv_c) = kvreg[j];
#pragma unroll
            for (int i = 0; i < 8; ++i) {
                const unsigned a0 = kvreg[0][i >> 1], a1 = kvreg[1][i >> 1], a2 = kvreg[2][i >> 1], a3 = kvreg[3][i >> 1];
                unsigned lo, hi2;
                if (i & 1) { lo = (a0 >> 16) | (a1 & 0xffff0000u); hi2 = (a2 >> 16) | (a3 & 0xffff0000u); }
                else { lo = (a0 & 0xffffu) | (a1 << 16); hi2 = (a2 & 0xffffu) | (a3 << 16); }
                *(LAS u32x2*)(KT + (8 * kv_c + i) * SP + ((((kv_g >> 1) ^ ((kv_c >> 1) & 7)) << 3) + 4 * (kv_g & 1))) = (u32x2){lo, hi2};
            }
        } else if (is_v) {
            const float w0 = sc[256 + 4 * v_g], w1 = sc[256 + 4 * v_g + 1], w2 = sc[256 + 4 * v_g + 2], w3 = sc[256 + 4 * v_g + 3];
#pragma unroll
            for (int i = 0; i < 8; ++i) {
                const unsigned a0 = kvreg[0][i >> 1], a1 = kvreg[1][i >> 1], a2 = kvreg[2][i >> 1], a3 = kvreg[3][i >> 1];
                unsigned lo, hi2; float f0, f1, f2, f3;
                if (i & 1) { lo = (a0 >> 16) | (a1 & 0xffff0000u); hi2 = (a2 >> 16) | (a3 & 0xffff0000u); f0 = bfhi(a0); f1 = bfhi(a1); f2 = bfhi(a2); f3 = bfhi(a3); }
                else { lo = (a0 & 0xffffu) | (a1 << 16); hi2 = (a2 & 0xffffu) | (a3 << 16); f0 = bflo(a0); f1 = bflo(a1); f2 = bflo(a2); f3 = bflo(a3); }
                const int vcol = (((v_g >> 1) ^ sw2(8 * v_c + i)) << 3) + 4 * (v_g & 1);
                *(LAS u32x2*)(VT + (8 * v_c + i) * SP + vcol) = (u32x2){lo, hi2};
                *(LAS u32x2*)(VW + (8 * v_c + i) * SP + vcol) = (u32x2){cvtpk(f0 * w0, f1 * w1), cvtpk(f2 * w2, f3 * w3)};
            }
        } else if (tid >= 320 && tid < 384) {
            VW[32 * SP + (tid - 320)] = f2bf(sc[256 + (tid - 320)]);
        }
    };
    prefetch(0);
    if (wid == 7) { gload(0); scalars(0); }
    __syncthreads();
    stage(0);
    for (int n = 0; n < 68; ++n) {
        LAS const float* sc = (LAS const float*)(lds + O_SC) + (n & 1) * SC_FLOATS;
        LAS const bf16* Cc = (LAS const bf16*)(lds + O_CS + (n & 1) * CS_BYTES);
        LAS bf16* Cn = (LAS bf16*)(lds + O_CS + ((n + 1) & 1) * CS_BYTES);
        __syncthreads();
        if (n + 1 < 68) { prefetch(n + 1); if (wid == 7) scalars(n + 1); }
        {
            const int tr = wid >> 1, tau = 16 * tr + fr; const float Mt = sc[64 + tau]; const float decay = sc[320];
            bf16x8 qa[4], kb[2][4], va[3][2], kt[2];
#pragma unroll
            for (int kk = 0; kk < 4; ++kk) { qa[kk] = *(const LAS bf16x8*)(Qs + (16 * tr + fr) * QP + 32 * kk + 8 * fq);
#pragma unroll
                for (int tt = 0; tt < 2; ++tt) kb[tt][kk] = *(const LAS bf16x8*)(Ks + (16 * (2 * (wid & 1) + tt) + fr) * QP + 32 * kk + 8 * fq); }
#pragma unroll
            for (int kk = 0; kk < 2; ++kk) { kt[kk] = *(const LAS bf16x8*)(KT + (16 * wid + fr) * SP + (((4 * kk + fq) ^ (wid & 7)) << 3));
#pragma unroll
                for (int tm = 0; tm < 3; ++tm) va[tm][kk] = *(const LAS bf16x8*)(VW + (16 * tm + fr) * SP + (((4 * kk + fq) ^ sw2(16 * tm + fr)) << 3)); }
            f32x4 s2[2] = {(f32x4){0.f, 0.f, 0.f, 0.f}, (f32x4){0.f, 0.f, 0.f, 0.f}};
#pragma unroll
            for (int tm = 0; tm < 3; ++tm) Cacc[tm] = Cacc[tm] * decay;
#pragma unroll
            for (int kk = 0; kk < 4; ++kk) {
#pragma unroll
                for (int tt = 0; tt < 2; ++tt) s2[tt] = __builtin_amdgcn_mfma_f32_16x16x32_bf16(kb[tt][kk], qa[kk], s2[tt], 0, 0, 0);
                if (kk < 2) {
#pragma unroll
                    for (int tm = 0; tm < 3; ++tm) Cacc[tm] = __builtin_amdgcn_mfma_f32_16x16x32_bf16(kt[kk], va[tm][kk], Cacc[tm], 0, 0, 0);
                }
            }
#pragma unroll
            for (int tt = 0; tt < 2; ++tt) {
                const int tc = 2 * (wid & 1) + tt;
                const int s0 = 16 * tc + 4 * fq; const f32x4 us = *(const LAS f32x4*)(sc + s0);
                float w[4];
#pragma unroll
                for (int i = 0; i < 4; ++i) w[i] = (s0 + i <= tau) ? s2[tt][i] * __expf(us[i] - Mt) : 0.f;
                *(LAS u32x2*)(Ps + tau * SP + ((((2 * tc + (fq >> 1)) ^ sw2(tau)) << 3) + 4 * (fq & 1))) = (u32x2){cvtpk(w[0], w[1]), cvtpk(w[2], w[3])};
            }
#pragma unroll
            for (int tm = 0; tm < 3; ++tm)
                *(LAS u32x2*)(Cn + (16 * tm + fr) * QP + ((((2 * wid + (fq >> 1)) ^ sw2(16 * tm + fr)) << 3) + 4 * (fq & 1))) = (u32x2){cvtpk(Cacc[tm][0], Cacc[tm][1]), cvtpk(Cacc[tm][2], Cacc[tm][3])};
        }
        __syncthreads();
        {
            const int tr = wid >> 1, tn = wid & 1, tau = 16 * tr + fr;
            f32x4 pv = (f32x4){0.f, 0.f, 0.f, 0.f}, cq = pv, pvd = pv, cqd = pv;
#pragma unroll
            for (int kk = 0; kk < 2; ++kk) {
                const bf16x8 af = *(const LAS bf16x8*)(Ps + (16 * tr + fr) * SP + (((4 * kk + fq) ^ sw2(16 * tr + fr)) << 3));
                const bf16x8 b0 = *(const LAS bf16x8*)(VT + (16 * tn + fr) * SP + (((4 * kk + fq) ^ sw2(16 * tn + fr)) << 3));
                const bf16x8 b1 = *(const LAS bf16x8*)(VT + (32 + fr) * SP + (((4 * kk + fq) ^ sw2(32 + fr)) << 3));
                pv = __builtin_amdgcn_mfma_f32_16x16x32_bf16(b0, af, pv, 0, 0, 0);
                pvd = __builtin_amdgcn_mfma_f32_16x16x32_bf16(b1, af, pvd, 0, 0, 0);
            }
#pragma unroll
            for (int kk = 0; kk < 4; ++kk) {
                const bf16x8 af = *(const LAS bf16x8*)(Qs + (16 * tr + fr) * QP + 32 * kk + 8 * fq);
                const bf16x8 b0 = *(const LAS bf16x8*)(Cc + (16 * tn + fr) * QP + (((4 * kk + fq) ^ sw2(16 * tn + fr)) << 3));
                const bf16x8 b1 = *(const LAS bf16x8*)(Cc + (32 + fr) * QP + (((4 * kk + fq) ^ sw2(32 + fr)) << 3));
                cq = __builtin_amdgcn_mfma_f32_16x16x32_bf16(b0, af, cq, 0, 0, 0);
                cqd = __builtin_amdgcn_mfma_f32_16x16x32_bf16(b1, af, cqd, 0, 0, 0);
            }
            const int rb = chunk_base(n);
            const float ai = sc[128 + tau];
            float den = (fq == 0) ? ai * cqd[0] + pvd[0] : 0.f;
            { auto r16_ = __builtin_amdgcn_permlane16_swap(__float_as_uint(den), __float_as_uint(den), false, false); den = __uint_as_float(r16_[0]) + __uint_as_float(r16_[1]); }
            { auto r32_ = __builtin_amdgcn_permlane32_swap(__float_as_uint(den), __float_as_uint(den), false, false); den = __uint_as_float(r32_[0]) + __uint_as_float(r32_[1]); }
            const float rden = 1.f / fmaxf(fabsf(den), sc[192 + tau]);
            float hv[4];
#pragma unroll
            for (int i = 0; i < 4; ++i) hv[i] = (ai * cq[i] + pv[i]) * rden;
            *(u32x2*)(PROJ + (size_t)grow(rb, tau) * NP + hcol + 16 * tn + 4 * fq) = (u32x2){cvtpk(hv[0], hv[1]), cvtpk(hv[2], hv[3])};
        }
        __syncthreads();
        if (n + 1 < 68) stage(n + 1);
    }
    __syncthreads();
}

__device__ __forceinline__ int lane_order_k(int kp) { const int t = kp & 255; return (kp & ~255) + 128 * ((t >> 3) & 1) + 32 * (t >> 6) + 16 * ((t >> 2) & 1) + 4 * ((t >> 4) & 3) + (t & 3); }
template <bool KPERM = false>
__device__ __forceinline__ void cvt_item(const float* W, int ldw, int K, int k0, int srccol0, bf16* dst, int dstrow0, LAS float* scr, int lane) {
    f32x4 wv[8];
#pragma unroll
    for (int i = 0; i < 8; ++i) { const int kk = 8 * i + (lane >> 3); const int ks = KPERM ? lane_order_k(k0 + kk) : (k0 + kk); wv[i] = *(const f32x4*)(W + (size_t)ks * ldw + srccol0 + 4 * (lane & 7)); }
#pragma unroll
    for (int i = 0; i < 8; ++i) { const int kk = 8 * i + (lane >> 3); LAS float* d = scr + kk * 33 + 4 * (lane & 7); d[0] = wv[i][0]; d[1] = wv[i][1]; d[2] = wv[i][2]; d[3] = wv[i][3]; }
    asm volatile("s_waitcnt lgkmcnt(0)" ::: "memory");
    const int c = lane & 7;
#pragma unroll
    for (int j = 0; j < 4; ++j) { const int n = (lane >> 3) + 8 * j; const LAS float* s = scr + (8 * c) * 33 + n;
        u32x4 o; o.x = cvtpk(s[0 * 33], s[1 * 33]); o.y = cvtpk(s[2 * 33], s[3 * 33]); o.z = cvtpk(s[4 * 33], s[5 * 33]); o.w = cvtpk(s[6 * 33], s[7 * 33]);
        *(u32x4*)(dst + (size_t)(dstrow0 + n) * K + k0 + 8 * c) = o; }
    asm volatile("s_waitcnt lgkmcnt(0)" ::: "memory");
}
template <int MODE, bool KPERM = false>
__device__ __forceinline__ void cvt_matrix(const float* W, int ldw, int K, int ngroups, int off, const float* W2, bf16* dst, LAS float* scr, int gw, int ngw, int lane) {
    const int kb = K / 64, items = ngroups * kb;
    for (int it = gw; it < items; it += ngw) {
        const int gidx = it / kb, k0 = 64 * (it % kb);
        const float* src = W; int sc;
        if (MODE == 0) sc = 32 * gidx + off;
        else if (MODE == 1) { const int tile = gidx >> 3, q = gidx & 7, bj = q >> 2, wc = q & 3; sc = 64 * (4 * tile + wc) + 32 * bj; }
        else { const int tile = gidx >> 3, q = gidx & 7; sc = 128 * tile + 32 * (q & 3); if (q >= 4) src = W2; }
        cvt_item<KPERM>(src, ldw, K, k0, sc, dst, 32 * gidx, scr, lane);
    }
}

__device__ __forceinline__ void load_row(const float* p, f32x4 (&v)[4], int lane) {
#pragma unroll
    for (int j = 0; j < 4; ++j) v[j] = *(const f32x4*)(p + 4 * lane + 256 * j);
}
__device__ __forceinline__ float row_rstd(const f32x4 (&v)[4]) {
    float s = 0.f;
#pragma unroll
    for (int j = 0; j < 4; ++j) s += (v[j][0] * v[j][0] + v[j][1] * v[j][1]) + (v[j][2] * v[j][2] + v[j][3] * v[j][3]);
    return 1.0f / sqrtf(wave_sum(s) * (1.f / 1024.f) + EPS);
}
__device__ __forceinline__ void norm_mod_row(f32x4 (&v)[4], const float* g, const float* sc, const float* sh, bf16* xn, int lane) {
    const float rstd = row_rstd(v);
#pragma unroll
    for (int j = 0; j < 4; ++j) {
        const int c = 4 * lane + 256 * j;
        const f32x4 gg = *(const f32x4*)(g + c), s1 = *(const f32x4*)(sc + c), s0 = *(const f32x4*)(sh + c);
        v[j] = v[j] * rstd * gg * (s1 + 1.0f) + s0;
        *(u32x2*)(xn + c) = (u32x2){cvtpk(v[j][0], v[j][1]), cvtpk(v[j][2], v[j][3])};
    }
}
__device__ __forceinline__ void load_vec(const float* p, f32x4 (&v)[4], int lane) {
#pragma unroll
    for (int j = 0; j < 4; ++j) v[j] = *(const f32x4*)(p + 4 * lane + 256 * j);
}
__device__ __forceinline__ void norm_mod_row_pre(f32x4 (&v)[4], const f32x4 (&g)[4], const f32x4 (&sc)[4], const f32x4 (&sh)[4], bf16* xn, int lane) {
    const float rstd = row_rstd(v);
#pragma unroll
    for (int j = 0; j < 4; ++j) {
        const int c = 4 * lane + 256 * j;
        v[j] = v[j] * rstd * g[j] * (sc[j] + 1.0f) + sh[j];
        *(u32x2*)(xn + c) = (u32x2){cvtpk(v[j][0], v[j][1]), cvtpk(v[j][2], v[j][3])};
    }
}
__device__ __forceinline__ void gates_row(const f32x4 (&v)[4], LAS const float* wg, const float* gate_b, float* gout, int lane) {
    float mine = 0.f;
#pragma unroll 1
    for (int q = 0; q < 16; ++q) {
        float a = 0.f;
#pragma unroll
        for (int j = 0; j < 4; ++j) { const f32x4 w = *(const LAS f32x4*)(wg + q * 1024 + 4 * lane + 256 * j); a += (v[j][0] * w[0] + v[j][1] * w[1]) + (v[j][2] * w[2] + v[j][3] * w[3]); }
        a = wave_sum(a);
        mine = (lane == q) ? a : mine;
    }
    if (lane < 16) { const float gq = mine + gate_b[lane]; gout[lane] = ((lane >> 2) & 1) ? logsigmoidf_(gq) : gq; }
}

__device__ __forceinline__ const float* in_ptr(LAS unsigned char* lds, int i) {
    unsigned off = PTAB_OFF + 8 * i; asm volatile("" : "+s"(off));
    const unsigned long long v = *(const LAS unsigned long long*)(lds + off);
    const unsigned lo = __builtin_amdgcn_readfirstlane((unsigned)v), hi = __builtin_amdgcn_readfirstlane((unsigned)(v >> 32));
    return (const float*)(uintptr_t)(((unsigned long long)hi << 32) | lo);
}
struct Args { const float* in[34]; float* out; unsigned char* ws; int ph_lo, ph_hi; };
constexpr int PH_PER_LAYER = 13, N_PHASES = 1 + 2 * PH_PER_LAYER;

__global__ void __launch_bounds__(NTHR, 2) mk_fwd(Args args) {
    extern __shared__ __attribute__((aligned(16))) unsigned char lds_raw[];
    LAS unsigned char* lds = (LAS unsigned char*)lds_raw;
    int tid = threadIdx.x, lane = tid & 63, wave = __builtin_amdgcn_readfirstlane(tid >> 6);
    const int G = gridDim.x, bid = blockIdx.x, ngw = G * NWAVES; int gw = bid * NWAVES + wave;
#define REFRESH() do { tid = threadIdx.x; asm volatile("" : "+v"(tid)); lane = tid & 63; wave = __builtin_amdgcn_readfirstlane(tid >> 6); gw = bid * NWAVES + wave; scr = (LAS float*)(lds + wave * 16384); } while (0)
    unsigned char* ws = args.ws;
    unsigned* ctl = (unsigned*)(ws + WS_CTL);
    volatile LAS unsigned* MISC = (volatile LAS unsigned*)(lds + MISC_OFF);
    for (int u = tid; u < (LDS_BYTES - RING_BYTES) / 4; u += NTHR) ((LAS unsigned*)(lds + RING_BYTES))[u] = 0u;
    if (tid == 0) {
#pragma unroll
        for (int i = 0; i < 34; ++i) ((LAS unsigned long long*)(lds + PTAB_OFF))[i] = (unsigned long long)(uintptr_t)args.in[i];
    }
    __syncthreads();
    const int lo = args.ph_lo, hi = args.ph_hi;
    if (hi - lo > 1) (void)xcd_barrier_post(ctl + CW_BAR, MISC + 8);
#define IN(k) (lo <= (k) && (k) < hi)
#ifndef PHM
#define PHM 0xffff
#endif
#define INJ(j) (((PHM >> (j)) & 1) && IN(pb + (j)))
#define SEAM(k) do { if (IN(k) && IN((k) + 1)) { XcdBarrier b_; b_.bar = (unsigned*)(args.ws + WS_CTL) + CW_BAR; b_.x = xb_xcc_id(); b_.st = (volatile LAS unsigned*)(lds + MISC_OFF) + 8; xcd_barrier(b_); } } while (0)

#define x_in in_ptr(lds, 0)
#define c_in in_ptr(lds, 1)
#define ctx_in in_ptr(lds, 2)
#define cctx_in in_ptr(lds, 3)
    float* MOD = (float*)(ws + WS_MOD); float* ROPEC = (float*)(ws + WS_ROPE); float* ROPES = ROPEC + 1024;
    float* GATES = (float*)(ws + WS_GATES); float* CTXRES = (float*)(ws + WS_CTXRES);
    bf16* XN = (bf16*)(ws + WS_R0); bf16* CQK = (bf16*)(ws + WS_CQK); bf16* PROJ = (bf16*)(ws + WS_R1);
    bf16* AO = (bf16*)(ws + WS_AO); bf16* BO = (bf16*)(ws + WS_BO); bf16* MO = (bf16*)(ws + WS_MO);
    bf16* GB = (bf16*)(ws + WS_G); bf16* UB = (bf16*)(ws + WS_U); bf16* Y = (bf16*)(ws + WS_Y); bf16* HB = (bf16*)(ws + WS_H); bf16* Y2 = (bf16*)(ws + WS_Y2);
    LAS float* scr = (LAS float*)(lds + wave * 16384);

    for (int rep0_ = 0; rep0_ < ((((PROBE_DUP) >> 15) & 1) ? 2 : 1); ++rep0_)
    if (IN(0)) {
        REFRESH();
        LAS float* sl = (LAS float*)lds;
        for (int i = tid; i < 9 * 1024; i += NTHR) { const int j = i >> 10, k = i & 1023; const float cv = j < 8 ? c_in[j * 1024 + k] : cctx_in[k]; sl[i] = siluf_(cv); }
        __syncthreads();
        LAS float* red = (LAS float*)(lds + 40960);
        for (int un = bid; un < 192; un += G) {
            const int l = un / 96, n0 = 64 * (un % 96), ks = tid >> 6, col = tid & 63;
            const float* w = in_ptr(lds, 4) + (size_t)l * 1024 * 6144 + n0 + col;
            float a[9];
#pragma unroll
            for (int j = 0; j < 9; ++j) a[j] = 0.f;
            for (int k = ks * 128; k < ks * 128 + 128; ++k) { const float wv = w[(size_t)k * 6144];
#pragma unroll
                for (int j = 0; j < 9; ++j) a[j] += sl[j * 1024 + k] * wv; }
#pragma unroll
            for (int j = 0; j < 9; ++j) red[(ks * 9 + j) * 64 + col] = a[j];
            __syncthreads();
            for (int i = tid; i < 9 * 64; i += NTHR) { const int j = i >> 6, cc = i & 63; float s = 0.f;
#pragma unroll
                for (int k2 = 0; k2 < 8; ++k2) s += red[(k2 * 9 + j) * 64 + cc];
                MOD[((size_t)l * 9 + j) * 6144 + n0 + cc] = s + in_ptr(lds, 5)[l * 6144 + n0 + cc]; }
            __syncthreads();
        }
        if (bid == (G > 200 ? 200 : 0)) {
            for (int i = tid; i < 1024; i += NTHR) { const int p = i >> 4, f = i & 15; const float inv = powf(10000.f, -(float)f / 16.f); const float ang = (float)p * inv; float s, c; sincosf(ang, &s, &c); ROPEC[i] = c; ROPES[i] = s; }
        }
        __syncthreads();
    }
    SEAM(0);

    for (int l = 0; l < 2; ++l) {
        const int pb = 1 + PH_PER_LAYER * l;
        const bool last = (l == 1);
        const float* modl = MOD + (size_t)l * 9 * 6144;
        const float* win = in_ptr(lds, 10) + (size_t)l * D * NIN;
        const float* xres_lat = (l == 0) ? x_in : args.out;
        const float* xres_ctx = (l == 0) ? ctx_in : CTXRES;
        const float lam_init = (l == 0) ? 0.2f : (0.8f - 0.6f * 0.7408182206817179f);

#define CVT_MIXER(LL) do { const float* win_ = in_ptr(lds, 10) + (size_t)(LL) * D * NIN; const float* wa_ = in_ptr(lds, 22) + (size_t)(LL) * 512 * 1024; \
            const float* wb_ = in_ptr(lds, 23) + (size_t)(LL) * 512 * 1024; const float* wc_ = in_ptr(lds, 24) + (size_t)(LL) * 512 * 1024; const float* wo_ = in_ptr(lds, 25) + (size_t)(LL) * 1024 * 1024; \
            constexpr int J_IN = (NP / 32) * 16, J_G = (3072 / 32) * 16, J_BR = 32 * 8, J_O = 32 * 16; \
            for (int it = gw; it < J_IN + J_G + 3 * J_BR + J_O; it += ngw) { int r = it; \
                if (r < J_IN) { const int gidx = r >> 4, k0 = 64 * (r & 15), tile = gidx >> 3, q = gidx & 7; cvt_item(win_, NIN, D, k0, 64 * (4 * tile + (q & 3)) + 32 * (q >> 2), (bf16*)(ws + W_IN), 32 * gidx, scr, lane); continue; } r -= J_IN; \
                if (r < J_G) { const int gidx = r >> 4, k0 = 64 * (r & 15); cvt_item(win_, NIN, D, k0, 4368 + 32 * gidx, (bf16*)(ws + W_G), 32 * gidx, scr, lane); continue; } r -= J_G; \
                if (r < 3 * J_BR) { const int br = r / J_BR, q = r - br * J_BR, gidx = q >> 3, k0 = 64 * (q & 7); cvt_item(br == 0 ? wa_ : (br == 1 ? wb_ : wc_), 1024, 512, k0, 32 * gidx, (bf16*)(ws + W_A) + (size_t)br * 512 * 1024, 32 * gidx, scr, lane); continue; } r -= 3 * J_BR; \
                { const int gidx = r >> 4, k0 = 64 * (r & 15); cvt_item<true>(wo_, 1024, 1024, k0, 32 * gidx, (bf16*)(ws + W_O), 32 * gidx, scr, lane); } } } while (0)
        REP(0) if (INJ(0) && l == 0) {
            REFRESH();
            CVT_MIXER(0);
            __syncthreads();
            LAS float* wg = (LAS float*)lds;
            for (int i = tid; i < 16 * 1024; i += NTHR) { const int k = i >> 4, q = i & 15; wg[q * 1024 + k] = win[(size_t)k * NIN + 4352 + q]; }
            __syncthreads();
            const float* xin_p = x_in; const float* cin_p = ctx_in; const float* pmg_h = in_ptr(lds, 6) + l * D; const float* gbp_h = in_ptr(lds, 20) + l * 16;
            for (int r = gw; r < R; r += ngw) {
                const int b = r / SEQ, pos = r % SEQ; const bool isc = pos < NCTX;
                const float* xr = isc ? cin_p + ((size_t)b * NCTX + pos) * D : xin_p + ((size_t)b * TLAT + pos - NCTX) * D;
                const float* md = modl + (size_t)(isc ? 8 : b) * 6144;
                f32x4 v[4], mgv[4], scv[4], shv[4]; load_row(xr, v, lane); load_vec(pmg_h, mgv, lane); load_vec(md + 1024, scv, lane); load_vec(md, shv, lane);
                norm_mod_row_pre(v, mgv, scv, shv, XN + (size_t)r * D, lane);
                gates_row(v, wg, gbp_h, GATES + (size_t)r * 16, lane);
            }
            __syncthreads();
        }
        if (l == 0) SEAM(pb + 0);

        REP(1) if (INJ(1)) {
            REFRESH();
            pg8::GemmP g{D, D, D}; InProjOrder S; S.G = G; S.c = bid; S.skip = last ? 1 : 0; S.A = (const char*)XN; S.B = (const char*)(ws + W_IN);
            LAS float* etab = (LAS float*)(lds + RING_BYTES + 4096);
            { const float* qgp = in_ptr(lds, 11) + l * 64; const float* kgp = in_ptr(lds, 12) + l * 64;
              for (int i = tid; i < 2176; i += NTHR) etab[i] = i < 2048 ? ROPEC[i] : (i < 2112 ? qgp[i - 2048] : kgp[i - 2112]); }
            __syncthreads();
            EpiInProj E{PROJ, etab + 2048, etab + 2112, etab, etab + 1024};
            pg8::gemm_phase(lds, g, S, E);
        }
        SEAM(pb + 1);

        REP(2) if (INJ(2)) {
            REFRESH();
            const int c8 = tid & 127, rsub = tid >> 7;
            const float* cw = in_ptr(lds, 18) + (size_t)l * 3 * 1024 + 8 * c8; const float* cb = in_ptr(lds, 19) + (size_t)l * 1024 + 8 * c8;
            float w0[8], w1[8], w2[8], bb[8];
#pragma unroll
            for (int i = 0; i < 8; ++i) { w0[i] = cw[i]; w1[i] = cw[1024 + i]; w2[i] = cw[2048 + i]; bb[i] = cb[i]; }
            const float ksc = c8 >= 64 ? 0.08838834764831845f : 1.f;
            const int nwk = G * 4, rpw = (R + nwk - 1) / nwk, r0 = (bid * 4 + rsub) * rpw, r1 = (r0 + rpw < R) ? r0 + rpw : R;
            for (int r = r0; r < r1; r += 4) {
                u32x4 xw[6];
#pragma unroll
                for (int k = 0; k < 6; ++k) { const int rr = r - 1 + k; const bool ok = (rr >= 0 && rr < R); const int rc = ok ? rr : r;
                    xw[k] = *(const u32x4*)(PROJ + (size_t)rc * NP + PC_Q + 8 * c8); if (!ok) xw[k] = (u32x4){0u, 0u, 0u, 0u}; }
#pragma unroll
                for (int k = 0; k < 4; ++k) { const int row = r + k;
                    if (row < r1) {
                        const int pos = row % SEQ;
                        const bool hasl = !(pos == 0 || pos == NCTX), hasr = !(pos == NCTX - 1 || pos == SEQ - 1);
                        const u32x4 z4 = (u32x4){0u, 0u, 0u, 0u};
                        const u32x4 xl = hasl ? xw[k] : z4, xc = xw[k + 1], xr = hasr ? xw[k + 2] : z4;
                        float o[8];
#pragma unroll
                        for (int i = 0; i < 8; ++i) {
                            const float a = (i & 1) ? bfhi(xl[i >> 1]) : bflo(xl[i >> 1]), bq = (i & 1) ? bfhi(xc[i >> 1]) : bflo(xc[i >> 1]), cq = (i & 1) ? bfhi(xr[i >> 1]) : bflo(xr[i >> 1]);
                            o[i] = siluf_(a * w0[i] + bq * w1[i] + cq * w2[i] + bb[i]) * ksc;
                        }
                        *(u32x4*)(CQK + (size_t)row * 1024 + 8 * c8) = (u32x4){cvtpk(o[0], o[1]), cvtpk(o[2], o[3]), cvtpk(o[4], o[5]), cvtpk(o[6], o[7])};
                    } }
            }
        }
        if (INJ(2)) {
            float* GSw = (float*)(ws + WS_MO);
            for (int task = gw; task < NB * 4 * 2 * 68; task += ngw) {
                const int n = task % 68, chain = task / 68, dir = chain & 1, h = (chain >> 1) & 3, b = chain >> 3;
                const int row0 = b * SEQ;
                const int rb = dir == 0 ? row0 + 64 * n : (n < 4 ? row0 + 64 * (3 - n) : row0 + 64 * (71 - n));
                const int row = dir == 0 ? rb + lane : rb + 63 - lane;
                const float* gp = GATES + (size_t)row * 16 + (dir == 0 ? 0 : 8) + h;
                const float ig = gp[0], lf = gp[4];
                float a = lf;
#pragma unroll
                for (int o = 1; o < 64; o <<= 1) { const float t = __shfl_up(a, o); if (lane >= o) a += t; }
                const float uu = ig - a;
                float mloc = uu;
#pragma unroll
                for (int o = 1; o < 64; o <<= 1) { const float t = __shfl_up(mloc, o); if (lane >= o) mloc = fmaxf(mloc, t); }
                float* o3 = GSw + (size_t)task * 192 + lane;
                o3[0] = uu; o3[64] = mloc; o3[128] = a;
            }
        }
        SEAM(pb + 2);

        REP(3) if (INJ(3)) {
            REFRESH();
            const bool x8 = (G == 256);
            const int vcu = x8 ? (bid & 7) * 32 + (bid >> 3) : bid;
#ifndef NO_MLSTM
            for (int rp_ = 0; rp_ < PROBE_ML; ++rp_)
            for (int id = vcu; id < 256; id += G) { const int chain = id >> 2; mlstm_unit(CQK, PROJ, (const float*)(ws + WS_MO), chain >> 3, (chain >> 1) & 3, chain & 1, id & 3, lds); }
#endif
            if (IN(pb + 3)) { XcdBarrier b_; b_.bar = (unsigned*)(args.ws + WS_CTL) + CW_BAR; b_.x = xb_xcc_id(); b_.st = (volatile LAS unsigned*)(lds + MISC_OFF) + 8; xcd_barrier(b_); }
            REFRESH();
            {
            const float* ng = in_ptr(lds, 21) + l * 128;
            for (int r = gw; r < R; r += ngw) {
                const bf16* pr = PROJ + (size_t)r * NP;
                const u32x4 hf = *(const u32x4*)(pr + PC_Q + 8 * lane), hb = *(const u32x4*)(pr + PC_K + 8 * lane), op = *(const u32x4*)(pr + PC_O + 8 * lane);
                float hs[8]; float ss = 0.f;
#pragma unroll
                for (int i = 0; i < 8; ++i) { hs[i] = ((i & 1) ? bfhi(hf[i >> 1]) : bflo(hf[i >> 1])) + ((i & 1) ? bfhi(hb[i >> 1]) : bflo(hb[i >> 1])); ss += hs[i] * hs[i]; }
                ss = row16_sum(ss);
                const float rstd = 1.0f / sqrtf(ss * (1.f / 128.f) + EPS);
                float o[8];
#pragma unroll
                for (int i = 0; i < 8; ++i) { const float og = (i & 1) ? bfhi(op[i >> 1]) : bflo(op[i >> 1]); o[i] = hs[i] * rstd * ng[(8 * lane + i) & 127] * sigmoidf_(og); }
                *(u32x4*)(MO + (size_t)r * 512 + 8 * lane) = (u32x4){cvtpk(o[0], o[1]), cvtpk(o[2], o[3]), cvtpk(o[4], o[5]), cvtpk(o[6], o[7])};
            }
            }
            float lam;
            { const float p1 = wave_sum(in_ptr(lds, 13)[l * 64 + lane] * in_ptr(lds, 14)[l * 64 + lane]), p2 = wave_sum(in_ptr(lds, 15)[l * 64 + lane] * in_ptr(lds, 16)[l * 64 + lane]); lam = __expf(p1) - __expf(p2) + lam_init; }
            const float* subg = in_ptr(lds, 17) + l * 128;
            for (int k = 0, id = vcu; id < 512; id += G, ++k) { int b = id >> 6, hh = (id >> 4) & 3, qb = id & 15;
                if (x8) { const int grp = 4 * (vcu >> 5) + (k >> 0) * 2 + ((vcu & 31) >> 4); b = grp >> 2; hh = grp & 3; qb = vcu & 15; }
#ifndef NO_ATTNB
                attn_unit_b(PROJ, BO, b * SEQ + NCTX + 256 * qb, b * SEQ, 68, hh, lam, 1.f - lam_init, subg, lds);
#endif
 }
            for (int k = 0, id = vcu; id < 1024; id += G, ++k) { int b = id >> 7, h = (id >> 4) & 7, qb = id & 15;
                if (x8) { const int grp = 2 * (vcu >> 5) + (k >> 1), u = (vcu & 31) + 32 * (k & 1); b = grp >> 1; h = 4 * (grp & 1) + (u >> 4); qb = u & 15; }
#ifndef NO_ATTNA
                attn_unit_a(PROJ, AO, b * SEQ + NCTX + 256 * qb, b * SEQ, 68, h, lds);
#endif
 }
            if (!last) {
                for (int id = bid; id < 96; id += G) {
#ifndef NO_ATTNC
                    if (id < 64) attn_unit_a(PROJ, AO, (id >> 3) * SEQ, (id >> 3) * SEQ, 4, id & 7, lds);
                    else { const int j = id - 64; attn_unit_b(PROJ, BO, (j >> 2) * SEQ, (j >> 2) * SEQ, 4, j & 3, lam, 1.f - lam_init, subg, lds); }
#endif
                }
            }
        }
        SEAM(pb + 3);


        REP(5) if (INJ(5)) {
            REFRESH();
            pg8::GemmP g{D, D, D}; pg8::StaticOrder S; S.init(R, 3072, G, bid, XN, D, ws + W_G, D, last ? 1 : 0);
            EpiSigmoid E{GB, 3072};
            pg8::gemm_phase(lds, g, S, E);
        }
        SEAM(pb + 5);

        REP(6) if (INJ(6)) {
            REFRESH();
            pg8::GemmP g{512, 512, 512}; MergeOrder S; S.lat = last ? 1 : 0; S.nM = last ? 128 : R / 256; S.nN = 4; S.nwg = S.nM * 4; S.G = G; S.c = bid;
            S.A0 = (const char*)AO; S.B0 = (const char*)(ws + W_A);
            EpiMerge E{GB, UB};
            pg8::gemm_phase(lds, g, S, E);
        }
        SEAM(pb + 6);

        REP(7) if (INJ(7)) {
            REFRESH();
            pg8::GemmP g{D, D, D}; pg8::StaticOrder S; S.init(R, D, G, bid, UB, D, ws + W_O, D, last ? 1 : 0);
            EpiBf16 E{Y, D};
            pg8::gemm_phase(lds, g, S, E);
            if (!last && bid >= 32) {
                REFRESH();
                const int cw = (bid - 32) * NWAVES + wave, ncw = (G - 32) * NWAVES;
                const float* wgp = in_ptr(lds, 26); const float* wup = in_ptr(lds, 27); const float* wdp = in_ptr(lds, 28);
                constexpr int I_GU = (2 * DFF / 32) * (D / 64), I_D = (D / 32) * (DFF / 64);
                for (int it = cw; it < I_GU + I_D; it += ncw) { int r = it;
                    if (r < I_GU) { const int gidx = r / (D / 64), k0 = 64 * (r % (D / 64)), tile = gidx >> 3, q = gidx & 7;
                        cvt_item((q >= 4 ? wup : wgp), DFF, D, k0, 128 * tile + 32 * (q & 3), (bf16*)(ws + WFF_GU), 32 * gidx, scr, lane); }
                    else { r -= I_GU; const int gidx = r / (DFF / 64), k0 = 64 * (r % (DFF / 64)); cvt_item(wdp, D, DFF, k0, 32 * gidx, (bf16*)(ws + WFF_D), 32 * gidx, scr, lane); } }
            }
        }
        SEAM(pb + 7);

        for (int rep_ = 0; rep_ < ((((PROBE_DUP) >> 8) & 1) && !last ? 2 : 1); ++rep_) if (INJ(8)) {
            REFRESH();
            LAS float* wrl = (LAS float*)lds;
            if (last) { for (int i = tid; i < 8 * 1024; i += NTHR) { const int k = i >> 3, e = i & 7; wrl[e * 1024 + k] = in_ptr(lds, 29)[(size_t)k * 8 + e]; } __syncthreads(); }
            int* TOKE = (int*)(ws + MOE_TOKE); int* TOKP = (int*)(ws + MOE_TOKP); float* TOKW = (float*)(ws + MOE_TOKW);
            int wcn[8] = {0, 0, 0, 0, 0, 0, 0, 0}; int nrw = 0, sv_t = 0, sv_e = 0, sv_p = 0; float sv_w = 0.f;
            const float* pog_h = in_ptr(lds, 7) + l * D; const float* pfg_h = in_ptr(lds, 8) + l * D; const float* brp_h = in_ptr(lds, 30);
            for (int r = gw; r < R; r += ngw) {
                const int b = r / SEQ, pos = r % SEQ; const bool isc = pos < NCTX;
                if (isc && last) continue;
                const float* xr = isc ? xres_ctx + ((size_t)b * NCTX + pos) * D : xres_lat + ((size_t)b * TLAT + pos - NCTX) * D;
                float* xo = isc ? CTXRES + ((size_t)b * NCTX + pos) * D : args.out + ((size_t)b * TLAT + pos - NCTX) * D;
                const float* md = modl + (size_t)(isc ? 8 : b) * 6144;
                f32x4 y[4], v[4], pgv[4], g1v[4], fgv[4], scv[4], shv[4];
                { u32x2 yb[4];
#pragma unroll
                  for (int j = 0; j < 4; ++j) yb[j] = *(const u32x2*)(Y + (size_t)r * D + 4 * lane + 256 * j);
#pragma unroll
                  for (int j = 0; j < 4; ++j) y[j] = (f32x4){bflo(yb[j].x), bfhi(yb[j].x), bflo(yb[j].y), bfhi(yb[j].y)}; }
                load_row(xr, v, lane); load_vec(pog_h, pgv, lane); load_vec(md + 2048, g1v, lane); load_vec(pfg_h, fgv, lane); load_vec(md + 4096, scv, lane); load_vec(md + 3072, shv, lane);
                const float rstd = row_rstd(y);
#pragma unroll
                for (int j = 0; j < 4; ++j) { const int c = 4 * lane + 256 * j;
                    v[j] = v[j] + g1v[j] * (y[j] * rstd * pgv[j]); *(f32x4*)(xo + c) = v[j]; }
                norm_mod_row_pre(v, fgv, scv, shv, XN + (size_t)r * D, lane);
                if (last) {
                    float lg[8];
#pragma unroll
                    for (int e = 0; e < 8; ++e) { float a = 0.f;
#pragma unroll
                        for (int j = 0; j < 4; ++j) { const f32x4 w = *(const LAS f32x4*)(wrl + e * 1024 + 4 * lane + 256 * j); a += (v[j][0] * w[0] + v[j][1] * w[1]) + (v[j][2] * w[2] + v[j][3] * w[3]); }
                        lg[e] = wave_sum(a) + brp_h[e]; }
                    int e0 = 0; float v0 = lg[0];
#pragma unroll
                    for (int e = 1; e < 8; ++e) if (lg[e] > v0) { v0 = lg[e]; e0 = e; }
                    int e1 = -1; float v1 = -INFINITY;
#pragma unroll
                    for (int e = 0; e < 8; ++e) if (e != e0 && lg[e] > v1) { v1 = lg[e]; e1 = e; }
                    const float w1 = 1.f / (1.f + __expf(v0 - v1)), w0 = 1.f - w1;
                    int lp0 = 0, lp1 = 0;
#pragma unroll
                    for (int e = 0; e < 8; ++e) { if (e == e0) { lp0 = wcn[e]; wcn[e] += 1; } if (e == e1) { lp1 = wcn[e]; wcn[e] += 1; } }
                    if (lane == nrw) { sv_t = b * TLAT + pos - NCTX; sv_e = e0 | (e1 << 8); sv_p = lp0 | (lp1 << 16); sv_w = w0; }
                    ++nrw;
                }
            }
            if (last) {
                LAS int* wcl = (LAS int*)(lds + 65536);
                int mycnt = 0;
#pragma unroll
                for (int e = 0; e < 8; ++e) mycnt = (lane == e) ? wcn[e] : mycnt;
                if (lane < 8) wcl[wave * 8 + lane] = mycnt;
                __syncthreads();
                if (wave == 0 && lane < 8) { int tot = 0;
#pragma unroll
                    for (int w = 0; w < 8; ++w) tot += wcl[w * 8 + lane];
                    int base = (int)atomicAdd(ctl + CW_CNT + 64 * lane, (unsigned)tot);
#pragma unroll
                    for (int w = 0; w < 8; ++w) { const int c = wcl[w * 8 + lane]; wcl[64 + w * 8 + lane] = base; base += c; } }
                __syncthreads();
                if (lane < nrw) { const int e0 = sv_e & 255, e1 = sv_e >> 8;
                    TOKE[2 * sv_t] = e0; TOKE[2 * sv_t + 1] = e1; TOKP[2 * sv_t] = wcl[64 + wave * 8 + e0] + (sv_p & 0xffff); TOKP[2 * sv_t + 1] = wcl[64 + wave * 8 + e1] + (sv_p >> 16);
                    TOKW[2 * sv_t] = sv_w; TOKW[2 * sv_t + 1] = 1.f - sv_w; }
            }
            __syncthreads();
        }
        SEAM(pb + 8);

        if (!last) {
            REP(9) if (INJ(9)) {
            REFRESH();
                pg8::GemmP g{D, D, D}; pg8::StaticOrder S; S.init(R, 2 * DFF, G, bid, XN, D, ws + WFF_GU, D);
                EpiSwiGLU E{HB, DFF};
                pg8::gemm_phase(lds, g, S, E);
            }
            SEAM(pb + 9);
            REP(10) if (INJ(10)) {
            REFRESH();
                pg8::GemmP g{DFF, DFF, DFF}; pg8::StaticOrder S; S.init(R, D, G, bid, HB, DFF, ws + WFF_D, DFF);
                EpiBf16 E{Y2, D};
                pg8::gemm_phase(lds, g, S, E);
            }
            SEAM(pb + 10);
            if (INJ(11)) {
            REFRESH();
                CVT_MIXER(1);
                __syncthreads();
                const float* win1 = in_ptr(lds, 10) + (size_t)D * NIN;
                const float* mod1 = MOD + (size_t)9 * 6144;
                LAS float* wg = (LAS float*)lds;
                for (int i = tid; i < 16 * 1024; i += NTHR) { const int k = i >> 4, q = i & 15; wg[q * 1024 + k] = win1[(size_t)k * NIN + 4352 + q]; }
                __syncthreads();
                const float* pfg_h = in_ptr(lds, 9) + l * D; const float* pmg1_h = in_ptr(lds, 6) + D; const float* gbp1_h = in_ptr(lds, 20) + 16;
                for (int r = gw; r < R; r += ngw) {
                    const int b = r / SEQ, pos = r % SEQ; const bool isc = pos < NCTX;
                    float* xo = isc ? CTXRES + ((size_t)b * NCTX + pos) * D : args.out + ((size_t)b * TLAT + pos - NCTX) * D;
                    const float* md = modl + (size_t)(isc ? 8 : b) * 6144;
                    const float* md1 = mod1 + (size_t)(isc ? 8 : b) * 6144;
                    f32x4 y[4], v[4], pgv[4], g2v[4], mgv[4], scv[4], shv[4]; load_row(xo, v, lane);
                    load_vec(pfg_h, pgv, lane); load_vec(md + 5120, g2v, lane); load_vec(pmg1_h, mgv, lane); load_vec(md1 + 1024, scv, lane); load_vec(md1, shv, lane);
#pragma unroll
                    for (int j = 0; j < 4; ++j) { const u32x2 a = *(const u32x2*)(Y2 + (size_t)r * D + 4 * lane + 256 * j); y[j] = (f32x4){bflo(a.x), bfhi(a.x), bflo(a.y), bfhi(a.y)}; }
                    const float rstd = row_rstd(y);
#pragma unroll
                    for (int j = 0; j < 4; ++j) { const int c = 4 * lane + 256 * j;
                        v[j] = v[j] + g2v[j] * (y[j] * rstd * pgv[j]); *(f32x4*)(xo + c) = v[j]; }
                    norm_mod_row_pre(v, mgv, scv, shv, XN + (size_t)r * D, lane);
                    gates_row(v, wg, gbp1_h, GATES + (size_t)r * 16, lane);
                }
                __syncthreads();
            }
            SEAM(pb + 11);
        } else {
            int* TOKE = (int*)(ws + MOE_TOKE); int* TOKP = (int*)(ws + MOE_TOKP); float* TOKW = (float*)(ws + MOE_TOKW);
            int* ROWSLOT = (int*)(ws + MOE_ROWSLOT); float* ROWW = (float*)(ws + MOE_ROWW);
            bf16* XG = (bf16*)(ws + WS_XG); bf16* HM = (bf16*)(ws + WS_HM); bf16* YS = (bf16*)(ws + WS_YS);
            REP(9) if (INJ(9)) {
            REFRESH();
                int tb[NEXP + 1], cnt[NEXP]; tb[0] = 0;
#pragma unroll
                for (int e = 0; e < NEXP; ++e) { cnt[e] = (int)__hip_atomic_load(ctl + CW_CNT + 64 * e, __ATOMIC_RELAXED, __HIP_MEMORY_SCOPE_AGENT); tb[e + 1] = tb[e] + (cnt[e] + 255) / 256; }
                for (int pr0 = gw * 4; pr0 < 2 * NB * TLAT; pr0 += ngw * 4) {
                    int rowq[4]; u32x4 va[4], vb[4];
#pragma unroll
                    for (int q = 0; q < 4; ++q) { const int pr = pr0 + q; const int e = TOKE[pr] & 7, p = TOKP[pr] & 0x7fff;
                        int base = 0;
#pragma unroll
                        for (int j = 0; j < NEXP; ++j) base = (j == e) ? tb[j] : base;
                        rowq[q] = min(base * 256 + p, XG_ROWS - 1); }
#pragma unroll
                    for (int q = 0; q < 4; ++q) { const int t = (pr0 + q) >> 1; const int b = t / TLAT, tt = t % TLAT; const size_t srow = (size_t)b * SEQ + NCTX + tt;
                        const u32x4* src = (const u32x4*)(XN + srow * D); va[q] = src[lane]; vb[q] = src[lane + 64]; }
#pragma unroll
                    for (int q = 0; q < 4; ++q) { u32x4* dst = (u32x4*)(XG + (size_t)rowq[q] * D); dst[lane] = va[q]; dst[lane + 64] = vb[q];
                        if (lane == 0) { ROWSLOT[rowq[q]] = pr0 + q; ROWW[rowq[q]] = TOKW[pr0 + q]; } }
                }
#pragma unroll
                for (int e = 0; e < NEXP; ++e) {
                    const int r0 = tb[e] * 256 + cnt[e], r1 = tb[e + 1] * 256;
                    for (int row = r0 + gw; row < r1; row += ngw) { u32x4* dst = (u32x4*)(XG + (size_t)row * D); unsigned z0 = 0u; asm volatile("" : "+v"(z0)); const u32x4 zz = (u32x4){z0, z0, z0, z0}; dst[lane] = zz; dst[lane + 64] = zz; if (lane == 0) { ROWSLOT[row] = -1; ROWW[row] = 0.f; } }
                }
                {
                    const float* wgp = in_ptr(lds, 31); const float* wup = in_ptr(lds, 32); const float* wdp = in_ptr(lds, 33);
                    constexpr int I_GU = (2 * DFE / 32) * (D / 64), I_D = (D / 32) * (DFE / 64), I_E = I_GU + I_D;
                    for (int it = gw; it < NEXP * I_E; it += ngw) {
                        const int e = it / I_E; int r = it - e * I_E;
                        if (r < I_GU) { const int gidx = r / (D / 64), k0 = 64 * (r % (D / 64)), tile = gidx >> 3, q = gidx & 7;
                            cvt_item((q >= 4 ? wup : wgp) + (size_t)e * D * DFE, DFE, D, k0, 128 * tile + 32 * (q & 3), (bf16*)(ws + WM_GU) + (size_t)e * 2 * DFE * D, 32 * gidx, scr, lane); }
                        else { r -= I_GU; const int gidx = r / (DFE / 64), k0 = 64 * (r % (DFE / 64));
                            cvt_item(wdp + (size_t)e * DFE * D, D, DFE, k0, 32 * gidx, (bf16*)(ws + WM_D) + (size_t)e * D * DFE, 32 * gidx, scr, lane); }
                    }
                }
                __syncthreads();
            }
            SEAM(pb + 9);
            REP(10) if (INJ(10)) {
            REFRESH();
                pg8::GemmP g{D, D, D}; MoeOrder S; S.tb[0] = 0;
#pragma unroll
                for (int e = 0; e < NEXP; ++e) { const int c = (int)__hip_atomic_load(ctl + CW_CNT + 64 * e, __ATOMIC_RELAXED, __HIP_MEMORY_SCOPE_AGENT); S.tb[e + 1] = S.tb[e] + (c + 255) / 256; }
                S.nN = 2 * DFE / 256; S.G = G; S.c = bid; S.A = (const char*)XG; S.B = (const char*)(ws + WM_GU); S.ta = (size_t)256 * D * 2; S.tb_tile = (size_t)256 * D * 2; S.tb_exp = (size_t)2 * DFE * D * 2;
                EpiSwiGLU E{HM, DFE};
                pg8::gemm_phase(lds, g, S, E);
            }
            SEAM(pb + 10);
            REP(11) if (INJ(11)) {
            REFRESH();
                pg8::GemmP g{DFE, DFE, DFE}; MoeOrder S; S.tb[0] = 0;
#pragma unroll
                for (int e = 0; e < NEXP; ++e) { const int c = (int)__hip_atomic_load(ctl + CW_CNT + 64 * e, __ATOMIC_RELAXED, __HIP_MEMORY_SCOPE_AGENT); S.tb[e + 1] = S.tb[e] + (c + 255) / 256; }
                S.nN = 4; S.G = G; S.c = bid; S.A = (const char*)HM; S.B = (const char*)(ws + WM_D); S.ta = (size_t)256 * DFE * 2; S.tb_tile = (size_t)256 * DFE * 2; S.tb_exp = (size_t)D * DFE * 2;
                EpiMoeDown E{YS, ROWSLOT, ROWW};
                pg8::gemm_phase(lds, g, S, E);
            }
            SEAM(pb + 11);
            REP(12) if (INJ(12)) {
            REFRESH();
                const float* pfg_h = in_ptr(lds, 9) + l * D;
                f32x4 pgv[4]; load_vec(pfg_h, pgv, lane);
                for (int t0 = gw; t0 < NB * TLAT; t0 += 2 * ngw) {
                    const int t1 = t0 + ngw; const bool h1 = t1 < NB * TLAT; const int t1c = h1 ? t1 : t0;
                    float* xo0 = args.out + (size_t)t0 * D; float* xo1 = args.out + (size_t)t1c * D;
                    f32x4 v0[4], v1[4], g0[4], g1[4]; u32x2 a0[4], b0[4], a1[4], b1[4];
                    load_row(xo0, v0, lane); load_row(xo1, v1, lane);
                    load_vec(modl + (size_t)(t0 / TLAT) * 6144 + 5120, g0, lane); load_vec(modl + (size_t)(t1c / TLAT) * 6144 + 5120, g1, lane);
#pragma unroll
                    for (int j = 0; j < 4; ++j) { const int c = 4 * lane + 256 * j;
                        a0[j] = *(const u32x2*)(YS + (size_t)(2 * t0) * D + c); b0[j] = *(const u32x2*)(YS + (size_t)(2 * t0 + 1) * D + c);
                        a1[j] = *(const u32x2*)(YS + (size_t)(2 * t1c) * D + c); b1[j] = *(const u32x2*)(YS + (size_t)(2 * t1c + 1) * D + c); }
                    f32x4 y0[4], y1[4];
#pragma unroll
                    for (int j = 0; j < 4; ++j) {
                        y0[j] = (f32x4){bflo(a0[j].x) + bflo(b0[j].x), bfhi(a0[j].x) + bfhi(b0[j].x), bflo(a0[j].y) + bflo(b0[j].y), bfhi(a0[j].y) + bfhi(b0[j].y)};
                        y1[j] = (f32x4){bflo(a1[j].x) + bflo(b1[j].x), bfhi(a1[j].x) + bfhi(b1[j].x), bflo(a1[j].y) + bflo(b1[j].y), bfhi(a1[j].y) + bfhi(b1[j].y)}; }
                    const float r0 = row_rstd(y0), r1 = row_rstd(y1);
#pragma unroll
                    for (int j = 0; j < 4; ++j) { const int c = 4 * lane + 256 * j;
                        *(f32x4*)(xo0 + c) = v0[j] + g0[j] * (y0[j] * r0 * pgv[j]);
                        if (h1) *(f32x4*)(xo1 + c) = v1[j] + g1[j] * (y1[j] * r1 * pgv[j]); }
                }
            }
        }
    }
#undef IN
#undef SEAM
#undef CVT_MIXER
}

extern "C" void kernel_launch(void* const* d_in, const int* in_sizes, int n_in, void* d_out, int out_size, void* d_ws, size_t ws_size, hipStream_t stream) {
    static int grid = 0;
    if (grid == 0) {
        if (n_in != 34 || out_size != NB * TLAT * D || ws_size < WS_END) { fprintf(stderr, "kernel_launch: unexpected problem (n_in %d out %d ws %zu)\n", n_in, out_size, ws_size); grid = -1; return; }
        int dev = 0, cus = 0, per_cu = 0;
        if (hipGetDevice(&dev) != hipSuccess || hipDeviceGetAttribute(&cus, hipDeviceAttributeMultiprocessorCount, dev) != hipSuccess) { grid = -1; return; }
        if (hipFuncSetAttribute((const void*)mk_fwd, hipFuncAttributeMaxDynamicSharedMemorySize, LDS_BYTES) != hipSuccess) { fprintf(stderr, "kernel_launch: hipFuncSetAttribute failed\n"); grid = -1; return; }
        if (hipOccupancyMaxActiveBlocksPerMultiprocessor(&per_cu, (const void*)mk_fwd, NTHR, LDS_BYTES) != hipSuccess || per_cu < 1) fprintf(stderr, "kernel_launch: occupancy query says %d\n", per_cu);
        (void)hipGetLastError();
        grid = cus;
    }
    if (grid < 0) return;
    if (hipMemsetAsync((char*)d_ws + WS_CTL, 0, CTL_BYTES, stream) != hipSuccess) return;
    Args a{};
    for (int i = 0; i < 34; ++i) a.in[i] = (const float*)d_in[i];
    a.out = (float*)d_out; a.ws = (unsigned char*)d_ws;
#if MK_SINGLE
    a.ph_lo = 0; a.ph_hi = N_PHASES;
    hipLaunchKernelGGL(mk_fwd, dim3(grid), dim3(NTHR), LDS_BYTES, stream, a);
#else
    for (int p = 0; p < N_PHASES; ++p) { a.ph_lo = p; a.ph_hi = p + 1; hipLaunchKernelGGL(mk_fwd, dim3(grid), dim3(NTHR), LDS_BYTES, stream, a); }
#endif
}
```

```cpp
#include <hip/hip_runtime.h>
#include <cstdio>
#include <cstdint>

#ifndef PROBE_ML
#define PROBE_ML 1
#endif
#ifndef PROBE_DUP
#define PROBE_DUP 0
#endif
#define REP(j) for (int rep_ = 0; rep_ < ((((PROBE_DUP) >> (j)) & 1) ? 2 : 1); ++rep_)
#ifndef MK_SINGLE
#define MK_SINGLE 1
#endif

#define LAS __attribute__((address_space(3)))
typedef unsigned short bf16;
typedef short bf16x8 __attribute__((ext_vector_type(8)));
typedef float f32x4 __attribute__((ext_vector_type(4)));
typedef float f32x16 __attribute__((ext_vector_type(16)));
typedef unsigned u32x4 __attribute__((ext_vector_type(4)));
typedef unsigned u32x2 __attribute__((ext_vector_type(2)));
typedef float f32x2_t __attribute__((ext_vector_type(2)));
typedef __bf16 bf16x2_t __attribute__((ext_vector_type(2)));

constexpr int NB = 8, TLAT = 4096, NCTX = 256, SEQ = NCTX + TLAT  , R = NB * SEQ  ;
constexpr int D = 1024, NIN = 7440, NP = 4352  ;
constexpr int DFF = 2816, NEXP = 8, DFE = 1408;
constexpr int PA_Q = 0, PA_K = 512, PA_V = 640, PB_Q = 768, PB_K = 1280, PB_V = 1792, PC_Q = 2304, PC_K = 2816, PC_V = 3328, PC_O = 3840;
constexpr float EPS = 1e-6f;
constexpr float C2 = 0.125f * 1.4426950408889634f;
constexpr int NWAVES = 8, NTHR = 512;

constexpr size_t MiB = 1u << 20;
constexpr size_t WS_CTL = 0, CTL_BYTES = 1 * MiB;
constexpr size_t WS_MOD = 1 * MiB;
constexpr size_t WS_ROPE = WS_MOD + 512 * 1024;
constexpr size_t WS_GATES = 2 * MiB;
constexpr size_t WS_MOE = 5 * MiB;
constexpr size_t WS_CTXRES = 7 * MiB;
constexpr size_t WS_W = 15 * MiB;
constexpr size_t W_IN = WS_W, W_G = W_IN + (size_t)NP * D * 2, W_A = W_G + (size_t)3072 * D * 2, W_B = W_A + (size_t)1024 * 512 * 2, W_C = W_B + (size_t)1024 * 512 * 2,
                 W_O = W_C + (size_t)1024 * 512 * 2, W_END = W_O + (size_t)D * D * 2;
static_assert(W_END <= 35 * MiB && W_B - W_A == MiB && W_C - W_B == MiB, "W region");
constexpr size_t WS_R0 = 35 * MiB;
constexpr size_t WS_R2 = 103 * MiB;
constexpr size_t WS_R1 = 205 * MiB;
constexpr size_t WS_CQK = WS_R2;
constexpr size_t WS_END = 494 * MiB;
constexpr size_t SZ_RD = (size_t)R * D * 2;
static_assert(SZ_RD == 68 * MiB && (size_t)R * NP * 2 == 289 * MiB, "sizes");
constexpr size_t WS_AO = WS_R2, WS_BO = WS_R2 + 34 * MiB, WS_MO = WS_R2 + 68 * MiB;
constexpr size_t WS_G = WS_R1, WS_U = WS_R1 + 204 * MiB, WS_Y = WS_R1, WS_H = WS_R1;
constexpr size_t WS_Y2 = WS_R2;
constexpr size_t WS_WFF = 171 * MiB;
constexpr size_t WFF_GU = WS_WFF, WFF_D = WS_WFF + (size_t)2 * DFF * D * 2;
static_assert(WFF_D + (size_t)D * DFF * 2 <= WS_R1, "ffn weights inside R2");
constexpr int XG_ROWS = 2 * NB * TLAT + NEXP * 256;
constexpr size_t WS_XG = WS_R2;
constexpr size_t WS_YS = WS_R2;
constexpr size_t WS_HM = 235 * MiB;
constexpr size_t WS_WM = 417 * MiB;
constexpr size_t WM_GU = WS_WM, WM_D = WS_WM + (size_t)NEXP * 2 * DFE * D * 2;
static_assert(WS_XG + (size_t)XG_ROWS * D * 2 <= WS_HM && WS_HM + (size_t)XG_ROWS * DFE * 2 <= WS_WM && WM_D + (size_t)NEXP * D * DFE * 2 <= WS_END, "moe map");
constexpr size_t MOE_TOKE = WS_MOE, MOE_TOKP = MOE_TOKE + 2 * 32768 * 4, MOE_TOKW = MOE_TOKP + 2 * 32768 * 4, MOE_ROWSLOT = MOE_TOKW + 2 * 32768 * 4, MOE_ROWW = MOE_ROWSLOT + (size_t)XG_ROWS * 4;
static_assert(MOE_ROWW + (size_t)XG_ROWS * 4 <= WS_CTXRES, "moe lists");
constexpr int CW_BAR = 4096;
constexpr int CW_CNT = 16384;

constexpr int RING_BYTES = 131072;
constexpr int MISC_OFF = RING_BYTES + 320;
constexpr int LDS_BYTES = 147456;
constexpr int PTAB_OFF = RING_BYTES + 1024;

__device__ __forceinline__ unsigned cvtpk(float lo, float hi) { f32x2_t v = {lo, hi}; bf16x2_t b = __builtin_convertvector(v, bf16x2_t); return __builtin_bit_cast(unsigned, b); }
__device__ __forceinline__ bf16 f2bf(float f) { return (bf16)(cvtpk(f, 0.f) & 0xffffu); }
__device__ __forceinline__ float bflo(unsigned w) { return __uint_as_float(w << 16); }
__device__ __forceinline__ float bfhi(unsigned w) { return __uint_as_float(w & 0xffff0000u); }
__device__ __forceinline__ float bf2f(bf16 h) { return __uint_as_float(((unsigned)h) << 16); }
__device__ __forceinline__ float sigmoidf_(float x) { return __builtin_amdgcn_rcpf(1.f + __builtin_amdgcn_exp2f(-1.4426950408889634f * x)); }
__device__ __forceinline__ float invsigmoidf_(float x) { return 1.f + __builtin_amdgcn_exp2f(fminf(-1.4426950408889634f * x, 20.f)); }
__device__ __forceinline__ float siluf_(float x) { return x * __builtin_amdgcn_rcpf(1.f + __builtin_amdgcn_exp2f(-1.4426950408889634f * x)); }
__device__ __forceinline__ float logsigmoidf_(float x) { const float e = __expf(-fabsf(x)); const float l1p = (e < 1e-4f) ? e * (1.f - 0.5f * e) : __logf(1.f + e); return fminf(x, 0.f) - l1p; }
__device__ __forceinline__ float dpp_add(float v, const int ctrl_sel) {
    int r;
    if (ctrl_sel == 0) r = __builtin_amdgcn_update_dpp(0, __builtin_bit_cast(int, v), 0xB1, 0xF, 0xF, true);
    else if (ctrl_sel == 1) r = __builtin_amdgcn_update_dpp(0, __builtin_bit_cast(int, v), 0x4E, 0xF, 0xF, true);
    else if (ctrl_sel == 2) r = __builtin_amdgcn_update_dpp(0, __builtin_bit_cast(int, v), 0x141, 0xF, 0xF, true);
    else r = __builtin_amdgcn_update_dpp(0, __builtin_bit_cast(int, v), 0x140, 0xF, 0xF, true);
    return v + __builtin_bit_cast(float, r);
}
__device__ __forceinline__ float row16_sum(float v) { v = dpp_add(v, 0); v = dpp_add(v, 1); v = dpp_add(v, 2); v = dpp_add(v, 3); return v; }
__device__ __forceinline__ float wave_sum(float v) {
    v = row16_sum(v);
    const int iv = __builtin_bit_cast(int, v);
    const float a = __builtin_bit_cast(float, __builtin_amdgcn_readlane(iv, 0)), b = __builtin_bit_cast(float, __builtin_amdgcn_readlane(iv, 16));
    const float c = __builtin_bit_cast(float, __builtin_amdgcn_readlane(iv, 32)), d = __builtin_bit_cast(float, __builtin_amdgcn_readlane(iv, 48));
    return (a + b) + (c + d);
}

#define XB_TMO      128
#define XB_XCNT(j)  (256  + 64 * (j))
#define XB_XSUB(j)  (1280 + 64 * (j))
#define XB_XGEN(j)  (2304 + 64 * (j))
#define XB_TOP      3328
#define XB_TOPGEN   3392
#define XCD_BAR_WORDS 3456
#define XB_SPIN_CAP (1u << 18)
__device__ __forceinline__ unsigned xb_ld(unsigned* p)              { return __hip_atomic_load(p, __ATOMIC_RELAXED, __HIP_MEMORY_SCOPE_AGENT); }
__device__ __forceinline__ unsigned xb_add(unsigned* p, unsigned v) { return __hip_atomic_fetch_add(p, v, __ATOMIC_RELAXED, __HIP_MEMORY_SCOPE_AGENT); }
__device__ __forceinline__ unsigned xb_xcc_id() { return (unsigned)__builtin_amdgcn_s_getreg((3 << 11) | 20) & 0xFu; }
#define XB_SPIN(cond, bar) do { unsigned _sp = 0; while (cond) { __builtin_amdgcn_s_sleep(1); \
    if ((++_sp & 255u) == 0u) { if (xb_ld(&(bar)[XB_TMO])) break; if (_sp > XB_SPIN_CAP) { atomicAdd(&(bar)[XB_TMO], 1u); break; } } } } while (0)
struct XcdBarrier { unsigned* bar; unsigned x; volatile LAS unsigned* st; };
__device__ __forceinline__ XcdBarrier xcd_barrier_post(unsigned* bar, volatile LAS unsigned* st) {
    XcdBarrier b; b.bar = bar; b.x = xb_xcc_id(); b.st = st;
    if (threadIdx.x == 0) (void)xb_add(&bar[XB_XCNT(b.x)], 1u);
    return b;
}
__device__ __forceinline__ void xcd_barrier_complete(unsigned* bar, unsigned x, unsigned& nloc, unsigned& nx) {
    const unsigned G = gridDim.x * gridDim.y * gridDim.z;
    unsigned sum, cnt, mine, sp = 0u;
    for (;;) {
        sum = 0u; cnt = 0u; mine = 0u;
#pragma unroll
        for (unsigned j = 0; j < 16; ++j) { const unsigned c = xb_ld(&bar[XB_XCNT(j)]); sum += c; cnt += (c > 0u) ? 1u : 0u; mine = (j == x) ? c : mine; }
        if (sum == G) break;
        __builtin_amdgcn_s_sleep(1);
        if ((++sp & 255u) == 0u) { if (xb_ld(&bar[XB_TMO])) break; if (sp > XB_SPIN_CAP) { atomicAdd(&bar[XB_TMO], 1u); break; } }
    }
    nloc = mine > 0u ? mine : 1u; nx = cnt > 0u ? cnt : 1u;
}
__device__ __forceinline__ void xcd_barrier(const XcdBarrier& b) {
    asm volatile("s_waitcnt vmcnt(0)" ::: "memory");
    __syncthreads();
    if (threadIdx.x == 0) {
        unsigned* bar = b.bar;
        __builtin_amdgcn_s_waitcnt(0);
        unsigned nloc = b.st[0], nx = b.st[1];
        if (nloc == 0u) { xcd_barrier_complete(bar, b.x, nloc, nx); b.st[0] = nloc; b.st[1] = nx; }
        const unsigned old = xb_add(&bar[XB_XSUB(b.x)], 1u);
        const unsigned gen = old / nloc;
        if (old + 1u == (gen + 1u) * nloc) {
            __builtin_amdgcn_fence(__ATOMIC_RELEASE, "agent");
            asm volatile("s_waitcnt vmcnt(0)" ::: "memory");
            const unsigned og = xb_add(&bar[XB_TOP], 1u);
            const unsigned tg = og / nx;
            if (og + 1u == (tg + 1u) * nx) xb_add(&bar[XB_TOPGEN], 1u);
            else XB_SPIN(xb_ld(&bar[XB_TOPGEN]) == tg, bar);
            __builtin_amdgcn_fence(__ATOMIC_ACQUIRE, "agent");
            xb_add(&bar[XB_XGEN(b.x)], 1u);
            asm volatile("s_waitcnt vmcnt(0)" ::: "memory");
        } else {
            XB_SPIN(xb_ld(&bar[XB_XGEN(b.x)]) == gen, bar);
            __builtin_amdgcn_fence(__ATOMIC_ACQUIRE, "agent");
            asm volatile("s_waitcnt vmcnt(0)" ::: "memory");
        }
    }
    __syncthreads();
}

namespace pg8 {
constexpr int BM = 256, BK = 64, HALF = 128, HTB = HALF * BK * 2, STAGE_BYTES = 8 * HTB, NXCD = 8, WGM = 8;
__host__ __device__ __forceinline__ int lds_byte(int r, int c) { const int st = (r >> 4) * 2 + (c >> 5), rr = r & 15, cc = c & 31, ob = rr * 64 + cc * 2; return st * 1024 + (ob ^ (((ob >> 9) & 1) << 5)); }
__host__ __device__ __forceinline__ void stage_rc(int b, int& Rr, int& C) { const int st = b / 1024, sb = b % 1024, swz = sb ^ (((sb >> 9) & 1) << 5); Rr = (st >> 1) * 16 + swz / 64; C = (st & 1) * 32 + (swz % 64) / 2; }

struct Unit { int pm, pn, aux; const char* a; const char* b; };
struct GemmP { int K, lda, ldb; };

__device__ __forceinline__ void tile_of(int L, int nM, int nN, int& pm, int& pn) {
    const int nwg = nM * nN;
    int wgid = L; { const int q = nwg / NXCD, r = nwg % NXCD, xcd = wgid % NXCD, off = wgid / NXCD; wgid = (xcd < r ? xcd * (q + 1) : r * (q + 1) + (xcd - r) * q) + off; }
    const int nig = WGM * nN, gid = wgid / nig, fm = gid * WGM, gsz = (nM - fm) < WGM ? (nM - fm) : WGM;
    pm = fm + ((wgid % nig) % gsz); pn = (wgid % nig) / gsz;
}
struct StaticOrder {
    static constexpr bool CHAIN = false;
    int nM, nN, nwg, G, c, lat; const char* A; const char* B; size_t ta, tb;
    __device__ void init(int M, int N, int G_, int c_, const void* A_, int lda, const void* B_, int ldb, int lat_ = 0) { nM = M / BM; if (lat_) nM = nM / 17 * 16; nN = N / BM; nwg = nM * nN; G = G_; c = c_; lat = lat_; A = (const char*)A_; B = (const char*)B_; ta = (size_t)BM * lda * 2; tb = (size_t)BM * ldb * 2; }
    __device__ __forceinline__ bool next(int i, Unit& u) const {
        const long L = (long)i * G + c; if (L >= nwg) return false;
        tile_of((int)L, nM, nN, u.pm, u.pn); if (lat) u.pm += (u.pm >> 4) + 1; u.aux = 0; u.a = A + (size_t)u.pm * ta; u.b = B + (size_t)u.pn * tb; return true;
    }
};

template <class Epi, class Sched>
__device__ __forceinline__ void gemm_phase(LAS unsigned char* lds, const GemmP g, const Sched& S, const Epi& E) {
    int tid_ = threadIdx.x; asm volatile("" : "+v"(tid_));
    const int tid = tid_, wid = __builtin_amdgcn_readfirstlane(tid >> 6), lane = tid & 63, wr = wid >> 2, wc = wid & 3, fr = lane & 15, fq = lane >> 4;
    const int K = g.K, nt = K / BK;
    unsigned voffA[2], voffB[2];
#pragma unroll
    for (int i = 0; i < 2; ++i) { int Rr, C; stage_rc(tid * 16 + i * 8192, Rr, C); voffA[i] = (unsigned)(Rr * g.lda + C) * 2u; voffB[i] = (unsigned)(Rr * g.ldb + C) * 2u; }
    const size_t kstep = (size_t)(BK * 2);
    const size_t hstepA = (size_t)HALF * g.lda * 2, hstepB = (size_t)HALF * g.ldb * 2;
    const unsigned ldsw = (unsigned)wid * 1024u;
    const int aoff = lds_byte(wr * 64 + fr, fq * 8), boff = lds_byte(wc * 32 + fr, fq * 8);
#define PG8_SA(b, h) (((b) * 2 + (h)) * HTB)
#define PG8_SB(b, h) ((4 + (b) * 2 + (h)) * HTB)
#define PG8_STAGE(bufoff, gbase, voff) do { _Pragma("unroll") for (int _i = 0; _i < 2; ++_i) \
        __builtin_amdgcn_global_load_lds((const unsigned*)((const char*)(gbase) + (voff)[_i]), (LAS unsigned*)(lds + (bufoff) + ldsw + _i * 8192), 16, 0, 0); } while (0)
#define PG8_LDA(dst, b, h) do { _Pragma("unroll") for (int m = 0; m < 4; ++m) _Pragma("unroll") for (int k = 0; k < 2; ++k) dst[m][k] = *(const LAS bf16x8*)(lds + PG8_SA(b, h) + aoff + m * 2048 + k * 1024); } while (0)
#define PG8_LDB(dst, b, h) do { _Pragma("unroll") for (int n = 0; n < 2; ++n) _Pragma("unroll") for (int k = 0; k < 2; ++k) dst[n][k] = *(const LAS bf16x8*)(lds + PG8_SB(b, h) + boff + n * 2048 + k * 1024); } while (0)
#define PG8_MMA(ai, bj, At, Bt) do { __builtin_amdgcn_s_setprio(1); _Pragma("unroll") for (int m = 0; m < 4; ++m) _Pragma("unroll") for (int n = 0; n < 2; ++n) _Pragma("unroll") for (int k = 0; k < 2; ++k) \
        acc[ai][bj][m][n] = __builtin_amdgcn_mfma_f32_16x16x32_bf16(Bt[n][k], At[m][k], acc[ai][bj][m][n], 0, 0, 0); __builtin_amdgcn_s_setprio(0); } while (0)
#define PG8_WAIT_V(n) asm volatile("s_waitcnt vmcnt(" #n ")" ::: "memory")
#define PG8_WAIT_L(n) asm volatile("s_waitcnt lgkmcnt(" #n ")" ::: "memory")
#define PG8_BAR __builtin_amdgcn_s_barrier()
#define PG8_SCHED __builtin_amdgcn_sched_barrier(0)
    Unit cur, nxt; int ui = 0;
    if (!S.next(0, cur)) return;
    f32x4 acc[2][2][4][2];
#pragma unroll
    for (int a = 0; a < 2; ++a)
#pragma unroll
        for (int b = 0; b < 2; ++b)
#pragma unroll
            for (int m = 0; m < 4; ++m)
#pragma unroll
                for (int n = 0; n < 2; ++n) acc[a][b][m][n] = (f32x4){0.f, 0.f, 0.f, 0.f};
    bf16x8 At[4][2], B0[2][2], B1[2][2];
    const char* cA = cur.a; const char* cB = cur.b;
    PG8_STAGE(PG8_SB(0, 0), cB, voffB); PG8_STAGE(PG8_SB(0, 1), cB + hstepB, voffB); PG8_STAGE(PG8_SA(0, 0), cA, voffA); PG8_STAGE(PG8_SA(0, 1), cA + hstepA, voffA);
    if (wr == 1) PG8_BAR;
    PG8_WAIT_V(2); PG8_BAR;
    PG8_STAGE(PG8_SB(1, 0), cB + kstep, voffB); PG8_STAGE(PG8_SA(1, 0), cA + kstep, voffA); PG8_STAGE(PG8_SB(1, 1), cB + hstepB + kstep, voffB);
    PG8_WAIT_V(6); PG8_BAR;
    for (;;) {
        const bool has_next = S.next(ui + 1, nxt);
        const char* nA = has_next ? nxt.a : cA; const char* nB = has_next ? nxt.b : cB;
        for (int t = 0; t < nt; t += 2) {
            const bool last = (t == nt - 2);
            const char* a1 = cA + (size_t)(t + 1) * kstep;
            const char* a2 = last ? nA : cA + (size_t)(t + 2) * kstep; const char* b2 = last ? nB : cB + (size_t)(t + 2) * kstep;
            const char* a3 = a2 + kstep; const char* b3 = b2 + kstep;
            PG8_LDB(B0, 0, 0); PG8_LDB(B1, 0, 1); PG8_SCHED; PG8_LDA(At, 0, 0); PG8_STAGE(PG8_SA(1, 1), a1 + hstepA, voffA);
            PG8_WAIT_V(8); PG8_WAIT_L(0); PG8_BAR; PG8_MMA(0, 0, At, B0); PG8_MMA(0, 1, At, B1); PG8_BAR; PG8_SCHED;
            PG8_LDA(At, 0, 1); PG8_STAGE(PG8_SB(0, 0), b2, voffB); PG8_STAGE(PG8_SB(0, 1), b2 + hstepB, voffB); PG8_STAGE(PG8_SA(0, 0), a2, voffA);
            PG8_WAIT_V(8); PG8_WAIT_L(0); PG8_BAR; PG8_MMA(1, 0, At, B0); PG8_MMA(1, 1, At, B1); PG8_BAR; PG8_SCHED;
            PG8_LDB(B0, 1, 0); PG8_LDB(B1, 1, 1); PG8_SCHED; PG8_LDA(At, 1, 0); PG8_STAGE(PG8_SA(0, 1), a2 + hstepA, voffA);
            PG8_WAIT_V(8); PG8_WAIT_L(0); PG8_BAR; PG8_MMA(0, 0, At, B0); PG8_MMA(0, 1, At, B1); PG8_BAR; PG8_SCHED;
            PG8_LDA(At, 1, 1); PG8_STAGE(PG8_SB(1, 0), b3, voffB); PG8_STAGE(PG8_SB(1, 1), b3 + hstepB, voffB); PG8_STAGE(PG8_SA(1, 0), a3, voffA);
            PG8_WAIT_V(8); PG8_WAIT_L(0); PG8_BAR; PG8_MMA(1, 0, At, B0); PG8_MMA(1, 1, At, B1); PG8_BAR; PG8_SCHED;
        }
        if (wr == 0) PG8_BAR;
        E(acc, cur, wr, wc, fr, fq);
        if (!has_next) break;
        if (!(Sched::CHAIN && nxt.aux != 0)) {
#pragma unroll
        for (int a = 0; a < 2; ++a)
#pragma unroll
            for (int b = 0; b < 2; ++b)
#pragma unroll
                for (int m = 0; m < 4; ++m)
#pragma unroll
                    for (int n = 0; n < 2; ++n) acc[a][b][m][n] = (f32x4){0.f, 0.f, 0.f, 0.f};
        }
        cur = nxt; cA = nA; cB = nB; ++ui;
        if (wr == 1) PG8_BAR;
    }
    PG8_WAIT_V(0);
    PG8_BAR;
#undef PG8_SA
#undef PG8_SB
#undef PG8_STAGE
#undef PG8_LDA
#undef PG8_LDB
#undef PG8_MMA
#undef PG8_WAIT_V
#undef PG8_WAIT_L
#undef PG8_BAR
#undef PG8_SCHED
}
}
using pg8::Unit;

#define EPI_ARGS f32x4 (&acc)[2][2][4][2], const Unit& u, int wr, int wc, int fr, int fq
struct EpiInProj {
    bf16* P; LAS const float* qg; LAS const float* kg; LAS const float* ropec; LAS const float* ropes;
    __device__ __forceinline__ void operator()(EPI_ARGS) const {
        const int slot = 4 * u.pn + wc;
        const bool is_q = slot < 8 || (slot >= 12 && slot < 20);
        const bool do_norm = slot < 10;
        const bool do_rope = (slot < 10 || (slot >= 12 && slot < 28)) && (u.pm % 17 != 0);
        LAS const float* g = slot < 8 ? qg : kg;
        const float qs = is_q ? C2 : 1.f;
#pragma unroll
        for (int ai = 0; ai < 2; ++ai)
#pragma unroll
            for (int m = 0; m < 4; ++m) {
                const int r = u.pm * 256 + ai * 128 + wr * 64 + m * 16 + fr;
                f32x4 v[2][2];
#pragma unroll
                for (int bj = 0; bj < 2; ++bj)
#pragma unroll
                    for (int n = 0; n < 2; ++n) v[bj][n] = acc[ai][bj][m][n];
                if (do_norm) {
                    float ss = 0.f;
#pragma unroll
                    for (int bj = 0; bj < 2; ++bj)
#pragma unroll
                        for (int n = 0; n < 2; ++n) ss += (v[bj][n][0] * v[bj][n][0] + v[bj][n][1] * v[bj][n][1]) + (v[bj][n][2] * v[bj][n][2] + v[bj][n][3] * v[bj][n][3]);
                    { auto r16_ = __builtin_amdgcn_permlane16_swap(__float_as_uint(ss), __float_as_uint(ss), false, false); ss = __uint_as_float(r16_[0]) + __uint_as_float(r16_[1]); }
                    { auto r32_ = __builtin_amdgcn_permlane32_swap(__float_as_uint(ss), __float_as_uint(ss), false, false); ss = __uint_as_float(r32_[0]) + __uint_as_float(r32_[1]); }
                    const float rstd = __builtin_amdgcn_rsqf(ss * (1.f / 64.f) + EPS);
#pragma unroll
                    for (int bj = 0; bj < 2; ++bj)
#pragma unroll
                        for (int n = 0; n < 2; ++n) v[bj][n] = v[bj][n] * rstd * *(LAS const f32x4*)(g + 32 * bj + 16 * n + 4 * fq);
                }
                if (do_rope) {
                    const int t = (r % SEQ) - NCTX;
#pragma unroll
                    for (int bj = 0; bj < 2; ++bj) {
                        const int p = bj == 0 ? (t >> 6) : (t & 63);
                        const f32x4 cs = *(LAS const f32x4*)(ropec + p * 16 + 4 * fq), sn = *(LAS const f32x4*)(ropes + p * 16 + 4 * fq);
                        const f32x4 x1 = v[bj][0], x2 = v[bj][1];
                        v[bj][0] = x1 * cs - x2 * sn; v[bj][1] = x2 * cs + x1 * sn;
                    }
                }
                bf16* rowp = P + (size_t)r * NP + 64 * slot + 16 * (fq & 1) + 8 * (fq >> 1);
#pragma unroll
                for (int bj = 0; bj < 2; ++bj) { const f32x4 o0 = v[bj][0] * qs, o1 = v[bj][1] * qs;
                    const auto rx = __builtin_amdgcn_permlane16_swap(cvtpk(o0[0], o0[1]), cvtpk(o1[0], o1[1]), false, false);
                    const auto ry = __builtin_amdgcn_permlane16_swap(cvtpk(o0[2], o0[3]), cvtpk(o1[2], o1[3]), false, false);
                    *(u32x4*)(rowp + 32 * bj) = (u32x4){rx[0], ry[0], rx[1], ry[1]}; }
                asm volatile("" ::: "memory");
            }
    }
};
struct EpiSigmoid {
    bf16* O; int ldc;
    __device__ __forceinline__ void operator()(EPI_ARGS) const {
        bf16* tp = O + ((size_t)(u.pm * 12 + u.pn) << 16) + (size_t)((wr * 4 + wc) * 8192 + (fq * 16 + fr) * 8);
#pragma unroll
        for (int ai = 0; ai < 2; ++ai)
#pragma unroll
            for (int m = 0; m < 4; ++m)
#pragma unroll
                for (int bj = 0; bj < 2; ++bj) { const f32x4 v0 = acc[ai][bj][m][0], v1 = acc[ai][bj][m][1];
                    *(u32x4*)(tp + ((ai * 4 + m) * 2 + bj) * 512) = (u32x4){cvtpk(invsigmoidf_(v0[0]), invsigmoidf_(v0[1])), cvtpk(invsigmoidf_(v0[2]), invsigmoidf_(v0[3])), cvtpk(invsigmoidf_(v1[0]), invsigmoidf_(v1[1])), cvtpk(invsigmoidf_(v1[2]), invsigmoidf_(v1[3]))}; }
    }
};
struct EpiMerge {
    const bf16* G; bf16* U;
    __device__ __forceinline__ void operator()(EPI_ARGS) const {
        const int row0 = u.pm * 256 + wr * 64 + fr, col0 = u.pn * 256 + wc * 64 + fq * 16; const int br = u.aux;
        const bf16* gb = G + ((size_t)(u.pm * 12 + br * 4 + u.pn) << 16) + (size_t)((wr * 4 + wc) * 8192 + (fq * 16 + fr) * 8);
#pragma unroll
        for (int ai = 0; ai < 2; ++ai) {
            u32x4 gw[4][2], hw[4][2];
#pragma unroll
            for (int m = 0; m < 4; ++m)
#pragma unroll
                for (int bj = 0; bj < 2; ++bj) { const bf16* gp = gb + ((ai * 4 + m) * 2 + bj) * 512; gw[m][bj] = *(const u32x4*)gp; if (br != 2) hw[m][bj] = *(const u32x4*)(gp + 4 * 65536); }
#pragma unroll
            for (int m = 0; m < 4; ++m)
#pragma unroll
                for (int bj = 0; bj < 2; ++bj) {
                    const u32x4 g4 = gw[m][bj];
                    float s[8] = {bflo(g4.x), bfhi(g4.x), bflo(g4.y), bfhi(g4.y), bflo(g4.z), bfhi(g4.z), bflo(g4.w), bfhi(g4.w)};
#pragma unroll
                    for (int i = 0; i < 8; ++i) s[i] = __builtin_amdgcn_rcpf(s[i]);
                    if (br != 2) {
                        const u32x4 h4 = hw[m][bj];
                        const float d[8] = {bflo(h4.x), bfhi(h4.x), bflo(h4.y), bfhi(h4.y), bflo(h4.z), bfhi(h4.z), bflo(h4.w), bfhi(h4.w)};
#pragma unroll
                        for (int i = 0; i < 8; ++i) s[i] *= d[i];
                    }
                    f32x4& v0 = acc[ai][bj][m][0]; f32x4& v1 = acc[ai][bj][m][1];
                    v0[0] *= s[0]; v0[1] *= s[1]; v0[2] *= s[2]; v0[3] *= s[3]; v1[0] *= s[4]; v1[1] *= s[5]; v1[2] *= s[6]; v1[3] *= s[7];
                    if (br == 2) *(u32x4*)(U + (size_t)(row0 + ai * 128 + m * 16) * 1024 + col0 + bj * 8) = (u32x4){cvtpk(v0[0], v0[1]), cvtpk(v0[2], v0[3]), cvtpk(v1[0], v1[1]), cvtpk(v1[2], v1[3])}; }
        }
    }
};
struct EpiF32 {
    float* C; int ldc;
    __device__ __forceinline__ void operator()(EPI_ARGS) const {
        const int row0 = u.pm * 256 + wr * 64 + fr, col0 = u.pn * 256 + wc * 32 + 4 * fq;
#pragma unroll
        for (int ai = 0; ai < 2; ++ai)
#pragma unroll
            for (int m = 0; m < 4; ++m) { float* rowp = C + (size_t)(row0 + ai * 128 + m * 16) * ldc + col0;
#pragma unroll
                for (int bj = 0; bj < 2; ++bj)
#pragma unroll
                    for (int n = 0; n < 2; ++n) *(f32x4*)(rowp + bj * 128 + n * 16) = acc[ai][bj][m][n]; }
    }
};
struct EpiBf16 {
    bf16* O; int ldc;
    __device__ __forceinline__ void operator()(EPI_ARGS) const {
        const int row0 = u.pm * 256 + wr * 64 + fr, col0 = u.pn * 256 + wc * 32 + 16 * (fq & 1) + 8 * (fq >> 1);
#pragma unroll
        for (int ai = 0; ai < 2; ++ai)
#pragma unroll
            for (int m = 0; m < 4; ++m) { bf16* rowp = O + (size_t)(row0 + ai * 128 + m * 16) * ldc + col0;
#pragma unroll
                for (int bj = 0; bj < 2; ++bj) { const f32x4 v0 = acc[ai][bj][m][0], v1 = acc[ai][bj][m][1];
                    const auto rx = __builtin_amdgcn_permlane16_swap(cvtpk(v0[0], v0[1]), cvtpk(v1[0], v1[1]), false, false);
                    const auto ry = __builtin_amdgcn_permlane16_swap(cvtpk(v0[2], v0[3]), cvtpk(v1[2], v1[3]), false, false);
                    *(u32x4*)(rowp + bj * 128) = (u32x4){rx[0], ry[0], rx[1], ry[1]}; } }
    }
};
struct EpiSwiGLU {
    bf16* H; int ldc;
    __device__ __forceinline__ void operator()(EPI_ARGS) const {
        const int row0 = u.pm * 256 + wr * 64 + fr, col0 = u.pn * 128 + wc * 32 + 16 * (fq & 1) + 8 * (fq >> 1);
#pragma unroll
        for (int ai = 0; ai < 2; ++ai)
#pragma unroll
            for (int m = 0; m < 4; ++m) { bf16* rowp = H + (size_t)(row0 + ai * 128 + m * 16) * ldc + col0;
                const f32x4 g0 = acc[ai][0][m][0], u0 = acc[ai][1][m][0], g1 = acc[ai][0][m][1], u1 = acc[ai][1][m][1];
                const auto rx = __builtin_amdgcn_permlane16_swap(cvtpk(siluf_(g0[0]) * u0[0], siluf_(g0[1]) * u0[1]), cvtpk(siluf_(g1[0]) * u1[0], siluf_(g1[1]) * u1[1]), false, false);
                const auto ry = __builtin_amdgcn_permlane16_swap(cvtpk(siluf_(g0[2]) * u0[2], siluf_(g0[3]) * u0[3]), cvtpk(siluf_(g1[2]) * u1[2], siluf_(g1[3]) * u1[3]), false, false);
                *(u32x4*)rowp = (u32x4){rx[0], ry[0], rx[1], ry[1]}; }
    }
};
struct EpiMoeDown {
    bf16* YS; const int* rowslot; const float* roww;
    __device__ __forceinline__ void operator()(EPI_ARGS) const {
        const int row0 = u.pm * 256 + wr * 64 + fr, col0 = u.pn * 256 + wc * 32 + 16 * (fq & 1) + 8 * (fq >> 1);
#pragma unroll
        for (int ai = 0; ai < 2; ++ai)
#pragma unroll
            for (int m = 0; m < 4; ++m) { const int r = row0 + ai * 128 + m * 16; int slot = rowslot[r]; if ((unsigned)slot >= 2u * NB * TLAT) slot = -1; const float w = roww[r];
                bf16* rowp = YS + (size_t)(slot < 0 ? 0 : slot) * 1024 + col0;
#pragma unroll
                for (int bj = 0; bj < 2; ++bj) { const f32x4 v0 = acc[ai][bj][m][0] * w, v1 = acc[ai][bj][m][1] * w;
                    const auto rx = __builtin_amdgcn_permlane16_swap(cvtpk(v0[0], v0[1]), cvtpk(v1[0], v1[1]), false, false);
                    const auto ry = __builtin_amdgcn_permlane16_swap(cvtpk(v0[2], v0[3]), cvtpk(v1[2], v1[3]), false, false);
                    if (slot >= 0) *(u32x4*)(rowp + bj * 128) = (u32x4){rx[0], ry[0], rx[1], ry[1]}; }
                asm volatile("" ::: "memory"); }
    }
};

struct InProjOrder {
    static constexpr bool CHAIN = false;
    int G, c, skip; const char* A; const char* B;
    __device__ __forceinline__ bool next(int i, Unit& u) const {
        const int L = i * G + c;
        if (L < 128 * 17) { pg8::tile_of(L, 128, 17, u.pm, u.pn); u.pm += (u.pm >> 4) + 1; }
        else { const int j = L - 128 * 17; int b, k;
            if (skip) { if (j >= 72) return false; b = j / 9; k = j - 9 * b; k += 2 + (k > 0 ? 2 : 0) + (k > 4 ? 2 : 0); } else { if (j >= 136) return false; b = j / 17; k = j - 17 * b; }
            u.pm = 17 * b; u.pn = k; }
        u.aux = 0; u.a = A + (size_t)u.pm * (256 * D * 2); u.b = B + (size_t)u.pn * (256 * D * 2); return true;
    }
};
struct MergeOrder {
    static constexpr bool CHAIN = true;
    int nM, nN, nwg, G, c, lat; const char *A0, *B0;
    __device__ __forceinline__ bool next(int i, Unit& u) const {
        const int ti = i / 3, br = i - 3 * ti; const long L = (long)ti * G + c; if (L >= nwg) return false;
        pg8::tile_of((int)L, nM, nN, u.pm, u.pn); if (lat) u.pm += (u.pm >> 4) + 1; u.aux = br;
        const char* a = A0 + (size_t)br * (34 * MiB); const char* b = B0 + (size_t)br * (1 * MiB);
        u.a = a + (size_t)u.pm * (256 * 512 * 2); u.b = b + (size_t)u.pn * (256 * 512 * 2); return true;
    }
};
struct MoeOrder {
    static constexpr bool CHAIN = false;
    int tb[NEXP + 1]; int nN, G, c; const char* A; const char* B; size_t ta, tb_tile, tb_exp;
    __device__ __forceinline__ bool next(int i, Unit& u) const {
        const long L = (long)i * G + c; const int nwg = tb[NEXP] * nN; if (L >= nwg) return false;
        const int rt = (int)L / nN, pn = (int)L % nN; int e = 0;
#pragma unroll
        for (int j = 1; j < NEXP; ++j) e += (rt >= tb[j]) ? 1 : 0;
        u.pm = rt; u.pn = pn; u.aux = e; u.a = A + (size_t)rt * ta; u.b = B + (size_t)e * tb_exp + (size_t)pn * tb_tile; return true;
    }
};

constexpr int AT_KP = 72;
constexpr int AT_KBYTES = 64 * AT_KP * 2;
typedef short v4i16_t __attribute__((ext_vector_type(4)));
template <int DV>
__device__ __forceinline__ void attn_pass(const bf16* qrow, const bf16* kbase, const bf16* vbase, int NT, LAS unsigned char* lds, f32x16 (&o)[DV / 32]) {
    constexpr int DB = DV / 32, VRB = DV * 2  , AT_BUF = 8192 + 64 * VRB, NVP = DV / 64  ;
    int tid_ = threadIdx.x; asm volatile("" : "+v"(tid_));
    const int tid = tid_, lane = tid & 63, wid = __builtin_amdgcn_readfirstlane(tid >> 6), r32 = lane & 31, hi = lane >> 5;
    bf16x8 qf[4];
#pragma unroll
    for (int ds = 0; ds < 4; ++ds) qf[ds] = *(const bf16x8*)(qrow + 16 * ds + 8 * hi);
    LAS unsigned char* qlds = lds + 4 * AT_BUF + wid * 4096;
    if (DV == 128) {
#pragma unroll
        for (int ds = 0; ds < 4; ++ds) *(LAS bf16x8*)(qlds + r32 * 128 + (((2 * ds + hi) ^ ((r32 >> 1) & 7)) * 16)) = qf[ds];
    }
#define AT_QF(ds) (DV == 64 ? qf[ds] : *(const LAS bf16x8*)(qlo_ + kr_off[ds]))
#pragma unroll
    for (int db = 0; db < DB; ++db)
#pragma unroll
        for (int r = 0; r < 16; ++r) o[db][r] = 0.f;
    f32x16 negm; const f32x16 zero16 = {0.f, 0.f, 0.f, 0.f, 0.f, 0.f, 0.f, 0.f, 0.f, 0.f, 0.f, 0.f, 0.f, 0.f, 0.f, 0.f};
#pragma unroll
    for (int r = 0; r < 16; ++r) negm[r] = 0.f;
    if (DV == 64) asm volatile("" : "+v"(negm));
    float mhat = 0.f, lsum = 0.f;
    const int drow = 8 * wid + (lane >> 3), dslot = lane & 7;
    const bf16* kptr = kbase + (size_t)drow * NP + 8 * (dslot ^ ((drow >> 1) & 7));
    const int vrow = (DV == 64) ? drow : 4 * wid + (lane >> 4);
    const int vchk = (DV == 64) ? (dslot ^ (4 * ((drow >> 1) & 1))) : ((lane & 15) ^ (4 * (vrow & 3)));
    const bf16* vptr = vbase + (size_t)vrow * NP + 8 * vchk;
    const unsigned dk_off = (unsigned)wid * 1024u, dv_off = 8192u + (unsigned)wid * 1024u, lds0 = (unsigned)(uintptr_t)lds;
    int kr_off[4];
#pragma unroll
    for (int ds = 0; ds < 4; ++ds) kr_off[ds] = r32 * 128 + (((2 * ds + hi) ^ ((r32 >> 1) & 7)) * 16);
    const int q4 = (lane & 15) >> 2, p4 = lane & 3, g1 = (lane >> 4) & 1;
    int vt_off[DB];
#pragma unroll
    for (int db = 0; db < DB; ++db) vt_off[db] = 8192 + (4 * hi + q4) * VRB + ((DV == 64 ? (db ^ (q4 >> 1)) : (db ^ q4)) * 64) + (2 * g1 + (p4 >> 1)) * 16 + 8 * (p4 & 1);
#define AT_GLDS(gsrc, ldsaddr) do { unsigned keep_; asm volatile("s_mov_b32 %0, m0\n\ts_mov_b32 m0, %2\n\ts_nop 0\n\tglobal_load_lds_dwordx4 %1, off\n\ts_mov_b32 m0, %0" : "=&s"(keep_) : "v"(gsrc), "s"(ldsaddr) : "memory"); } while (0)
#define AT_DMA(J) do { \
        AT_GLDS(kptr, (unsigned)__builtin_amdgcn_readfirstlane(lds0 + (J) * AT_BUF + dk_off)); \
        AT_GLDS(vptr, (unsigned)__builtin_amdgcn_readfirstlane(lds0 + (J) * AT_BUF + dv_off)); \
        if (NVP == 2) AT_GLDS(vptr + (size_t)32 * NP, (unsigned)__builtin_amdgcn_readfirstlane(lds0 + (J) * AT_BUF + dv_off + 8192u)); \
        kptr += (size_t)64 * NP; vptr += (size_t)64 * NP; } while (0)
#define AT_VTR(p) __builtin_amdgcn_ds_read_tr16_b64_v4i16((LAS v4i16_t*)(p))
#define AT_QK(PN, KB, BLK) do { LAS unsigned char* qlo_ = qlds; asm volatile("" : "+v"(qlo_)); _Pragma("unroll") for (int ds = 0; ds < 4; ++ds) { \
            const bf16x8 kf = *(const LAS bf16x8*)((KB) + kr_off[ds] + 4096 * (BLK)); \
            PN = __builtin_amdgcn_mfma_f32_32x32x16_bf16(kf, AT_QF(ds), ds == 0 ? (DV == 64 ? negm : zero16) : PN, 0, 0, 0); } } while (0)
#define AT_VRD(VL, VH, KS, VBP, BLKP) do { _Pragma("unroll") for (int db = 0; db < DB; ++db) { \
            VL[db] = AT_VTR((VBP) + vt_off[db] + (32 * (BLKP) + 16 * (KS)) * VRB); VH[db] = AT_VTR((VBP) + vt_off[db] + (32 * (BLKP) + 16 * (KS) + 8) * VRB); } } while (0)
#define AT_VF(VL, VH, db) ((bf16x8){VL[db][0], VL[db][1], VL[db][2], VL[db][3], VH[db][0], VH[db][1], VH[db][2], VH[db][3]})
#define AT_PVM(VL, VH, PF, db) o[db] = __builtin_amdgcn_mfma_f32_32x32x16_bf16(AT_VF(VL, VH, db), PF, o[db], 0, 0, 0)
#define AT_QKM(PN, ds) PN = __builtin_amdgcn_mfma_f32_32x32x16_bf16(kf_[ds], AT_QF(ds), (ds) == 0 ? (DV == 64 ? negm : zero16) : PN, 0, 0, 0)
#define AT_EXPS(PC) do { float rs_ = 0.f; \
        _Pragma("unroll") for (int r = 0; r < 16; ++r) { const float e_ = __builtin_amdgcn_exp2f(DV == 64 ? PC[r] : PC[r] - mhat); PC[r] = e_; rs_ += e_; } \
        lsum += rs_; \
        np0_.x = cvtpk(PC[0], PC[1]); np0_.y = cvtpk(PC[2], PC[3]); np0_.z = cvtpk(PC[4], PC[5]); np0_.w = cvtpk(PC[6], PC[7]); \
        np1_.x = cvtpk(PC[8], PC[9]); np1_.y = cvtpk(PC[10], PC[11]); np1_.z = cvtpk(PC[12], PC[13]); np1_.w = cvtpk(PC[14], PC[15]); } while (0)
#define AT_SCALE_PK(W, F) do { W.x = cvtpk(bflo(W.x) * (F), bfhi(W.x) * (F)); W.y = cvtpk(bflo(W.y) * (F), bfhi(W.y) * (F)); W.z = cvtpk(bflo(W.z) * (F), bfhi(W.z) * (F)); W.w = cvtpk(bflo(W.w) * (F), bfhi(W.w) * (F)); } while (0)
#define AT_STEP_OLD(PC, PN, DO_QK, KB, NBLK, HAVE_PREV, VBP, BLKP, FIRST) do { \
        bf16x8 kf_[4]; LAS unsigned char* qlo_ = qlds; asm volatile("" : "+v"(qlo_)); \
        if (DV == 64 && (DO_QK)) { _Pragma("unroll") for (int ds = 0; ds < 4; ++ds) kf_[ds] = *(const LAS bf16x8*)((KB) + kr_off[ds] + 4096 * (NBLK)); } \
        if (HAVE_PREV) { _Pragma("unroll") for (int ks = 0; ks < 2; ++ks) { v4i16_t vl_[DB], vh_[DB]; \
            _Pragma("unroll") for (int db = 0; db < DB; ++db) { \
                vl_[db] = AT_VTR((VBP) + vt_off[db] + (32 * (BLKP) + 16 * ks) * VRB); vh_[db] = AT_VTR((VBP) + vt_off[db] + (32 * (BLKP) + 16 * ks + 8) * VRB); } \
            const bf16x8 pf_ = __builtin_bit_cast(bf16x8, ks == 0 ? pwp0 : pwp1); \
            _Pragma("unroll") for (int db = 0; db < DB; ++db) { \
                const bf16x8 vf_ = (bf16x8){vl_[db][0], vl_[db][1], vl_[db][2], vl_[db][3], vh_[db][0], vh_[db][1], vh_[db][2], vh_[db][3]}; \
                o[db] = __builtin_amdgcn_mfma_f32_32x32x16_bf16(vf_, pf_, o[db], 0, 0, 0); } \
            if (DV == 128) __builtin_amdgcn_sched_barrier(0); } } \
        if (DV == 128 && (DO_QK)) { _Pragma("unroll") for (int ds = 0; ds < 4; ++ds) kf_[ds] = *(const LAS bf16x8*)((KB) + kr_off[ds] + 4096 * (NBLK)); } \
        __builtin_amdgcn_sched_barrier(0); \
        float a_ = __builtin_fmaxf(__builtin_fmaxf(PC[0], PC[1]), PC[2]), b_ = __builtin_fmaxf(__builtin_fmaxf(PC[3], PC[4]), PC[5]); \
        a_ = __builtin_fmaxf(__builtin_fmaxf(a_, PC[6]), PC[7]); b_ = __builtin_fmaxf(__builtin_fmaxf(b_, PC[8]), PC[9]); \
        a_ = __builtin_fmaxf(__builtin_fmaxf(a_, PC[10]), PC[11]); b_ = __builtin_fmaxf(__builtin_fmaxf(b_, PC[12]), PC[13]); \
        a_ = __builtin_fmaxf(__builtin_fmaxf(a_, PC[14]), PC[15]); \
        float rm_ = __builtin_fmaxf(a_, b_); \
        { auto rr_ = __builtin_amdgcn_permlane32_swap(__float_as_uint(rm_), __float_as_uint(rm_), false, false); rm_ = __builtin_fmaxf(__uint_as_float(rr_[0]), __uint_as_float(rr_[1])); } \
        if (DV == 128) rm_ -= mhat; \
        if ((FIRST) || __any(rm_ > 8.f)) { const float dl_ = (FIRST) ? rm_ : __builtin_fmaxf(rm_, 0.f); mhat += dl_; \
            if (DV == 64) { _Pragma("unroll") for (int r = 0; r < 16; ++r) PC[r] -= dl_; \
                _Pragma("unroll") for (int r = 0; r < 16; ++r) negm[r] = -mhat; asm volatile("" : "+v"(negm)); } \
            const float f_ = __builtin_amdgcn_exp2f(-dl_); lsum *= f_; \
            _Pragma("unroll") for (int db = 0; db < DB; ++db) _Pragma("unroll") for (int r = 0; r < 16; ++r) o[db][r] *= f_; } \
        __builtin_amdgcn_sched_barrier(0); \
        if (DO_QK) { _Pragma("unroll") for (int ds = 0; ds < 4; ++ds) PN = __builtin_amdgcn_mfma_f32_32x32x16_bf16(kf_[ds], AT_QF(ds), ds == 0 ? (DV == 64 ? negm : zero16) : PN, 0, 0, 0); } \
        { float rs_ = 0.f; \
          _Pragma("unroll") for (int r = 0; r < 16; ++r) { const float e_ = __builtin_amdgcn_exp2f(DV == 64 ? PC[r] : PC[r] - mhat); PC[r] = e_; rs_ += e_; } \
          lsum += rs_; } \
        pwp0.x = cvtpk(PC[0], PC[1]); pwp0.y = cvtpk(PC[2], PC[3]); pwp0.z = cvtpk(PC[4], PC[5]); pwp0.w = cvtpk(PC[6], PC[7]); \
        pwp1.x = cvtpk(PC[8], PC[9]); pwp1.y = cvtpk(PC[10], PC[11]); pwp1.z = cvtpk(PC[12], PC[13]); pwp1.w = cvtpk(PC[14], PC[15]); \
        if (DO_QK) { __builtin_amdgcn_sched_group_barrier(0x002, 6, 0); \
            _Pragma("unroll") for (int i_ = 0; i_ < 4; ++i_) { __builtin_amdgcn_sched_group_barrier(0x008, 1, 0); __builtin_amdgcn_sched_group_barrier(0x002, 9, 0); } } \
        __builtin_amdgcn_sched_barrier(0); } while (0)
#define AT_STEP_NEW(PC, PN, DO_QK, KB, NBLK, HAVE_PREV, VBP, BLKP, FIRST) do { \
        bf16x8 kf_[4]; v4i16_t vl0_[DB], vh0_[DB], vl1_[DB], vh1_[DB]; u32x4 np0_, np1_; LAS unsigned char* qlo_ = qlds; asm volatile("" : "+v"(qlo_)); \
        if (DO_QK) { _Pragma("unroll") for (int ds = 0; ds < (DV == 64 ? 4 : 2); ++ds) kf_[ds] = *(const LAS bf16x8*)((KB) + kr_off[ds] + 4096 * (NBLK)); } \
        if (HAVE_PREV) { AT_VRD(vl0_, vh0_, 0, VBP, BLKP); if (DV == 64) AT_VRD(vl1_, vh1_, 1, VBP, BLKP); } \
        __builtin_amdgcn_sched_barrier(0); \
        float a_ = __builtin_fmaxf(__builtin_fmaxf(PC[0], PC[1]), PC[2]), b_ = __builtin_fmaxf(__builtin_fmaxf(PC[3], PC[4]), PC[5]); \
        a_ = __builtin_fmaxf(__builtin_fmaxf(a_, PC[6]), PC[7]); b_ = __builtin_fmaxf(__builtin_fmaxf(b_, PC[8]), PC[9]); \
        a_ = __builtin_fmaxf(__builtin_fmaxf(a_, PC[10]), PC[11]); b_ = __builtin_fmaxf(__builtin_fmaxf(b_, PC[12]), PC[13]); \
        a_ = __builtin_fmaxf(__builtin_fmaxf(a_, PC[14]), PC[15]); \
        float rm_ = __builtin_fmaxf(a_, b_); \
        { auto rr_ = __builtin_amdgcn_permlane32_swap(__float_as_uint(rm_), __float_as_uint(rm_), false, false); rm_ = __builtin_fmaxf(__uint_as_float(rr_[0]), __uint_as_float(rr_[1])); } \
        if (DV == 128) rm_ -= mhat; \
        if ((FIRST) || __any(rm_ > 8.f)) {     \
            const float dl_ = (FIRST) ? rm_ : __builtin_fmaxf(rm_, 0.f); mhat += dl_; \
            if (DV == 64) { _Pragma("unroll") for (int r = 0; r < 16; ++r) PC[r] -= dl_; \
                _Pragma("unroll") for (int r = 0; r < 16; ++r) negm[r] = -mhat; asm volatile("" : "+v"(negm)); } \
            const float f_ = __builtin_amdgcn_exp2f(-dl_); lsum *= f_; \
            _Pragma("unroll") for (int db = 0; db < DB; ++db) _Pragma("unroll") for (int r = 0; r < 16; ++r) o[db][r] *= f_; \
            if (HAVE_PREV) { AT_SCALE_PK(pwp0, f_); AT_SCALE_PK(pwp1, f_); } } \
        __builtin_amdgcn_sched_barrier(0); \
        const bf16x8 pf0_ = __builtin_bit_cast(bf16x8, pwp0), pf1_ = __builtin_bit_cast(bf16x8, pwp1); \
        if (DV == 64) { \
            if (DO_QK) AT_QKM(PN, 0); if (HAVE_PREV) AT_PVM(vl0_, vh0_, pf0_, 0); \
            if (DO_QK) AT_QKM(PN, 1); if (HAVE_PREV) AT_PVM(vl0_, vh0_, pf0_, 1); \
            if (DO_QK) AT_QKM(PN, 2); if (HAVE_PREV) AT_PVM(vl1_, vh1_, pf1_, 0); \
            if (DO_QK) AT_QKM(PN, 3); if (HAVE_PREV) AT_PVM(vl1_, vh1_, pf1_, 1); \
            AT_EXPS(PC); \
            if ((DO_QK) && (HAVE_PREV)) { _Pragma("unroll") for (int i_ = 0; i_ < 8; ++i_) { __builtin_amdgcn_sched_group_barrier(0x008, 1, 0); __builtin_amdgcn_sched_group_barrier(0x002, 5, 0); } } \
        } else { \
            if (DO_QK) AT_QKM(PN, 0); if (HAVE_PREV) { AT_PVM(vl0_, vh0_, pf0_, 0); AT_PVM(vl0_, vh0_, pf0_, 1); } \
            if (DO_QK) { AT_QKM(PN, 1); _Pragma("unroll") for (int ds = 2; ds < 4; ++ds) kf_[ds] = *(const LAS bf16x8*)((KB) + kr_off[ds] + 4096 * (NBLK)); } \
            if (HAVE_PREV) { AT_PVM(vl0_, vh0_, pf0_, 2); AT_PVM(vl0_, vh0_, pf0_, 3); AT_VRD(vl1_, vh1_, 1, VBP, BLKP); } \
            if (DO_QK) AT_QKM(PN, 2); if (HAVE_PREV) { AT_PVM(vl1_, vh1_, pf1_, 0); AT_PVM(vl1_, vh1_, pf1_, 1); } \
            if (DO_QK) AT_QKM(PN, 3); if (HAVE_PREV) { AT_PVM(vl1_, vh1_, pf1_, 2); AT_PVM(vl1_, vh1_, pf1_, 3); } \
            AT_EXPS(PC); \
        } \
        pwp0 = np0_; pwp1 = np1_; \
        __builtin_amdgcn_sched_barrier(0); } while (0)
#define AT_STEP(PC, PN, DO_QK, KB, NBLK, HAVE_PREV, VBP, BLKP, FIRST) do { if constexpr (DV == 64) AT_STEP_NEW(PC, PN, DO_QK, KB, NBLK, HAVE_PREV, VBP, BLKP, FIRST); else AT_STEP_OLD(PC, PN, DO_QK, KB, NBLK, HAVE_PREV, VBP, BLKP, FIRST); } while (0)
    f32x16 pa, pb; u32x4 pwp0, pwp1;
    AT_DMA(0); AT_DMA(1); AT_DMA(2);
    if (NVP == 2) asm volatile("s_waitcnt vmcnt(6)" ::: "memory"); else asm volatile("s_waitcnt vmcnt(4)" ::: "memory");
    __builtin_amdgcn_s_barrier(); asm volatile("" ::: "memory");
    AT_QK(pa, lds, 0);
#define AT_TILE(J, FIRST) do { const int t = t0 + (J); \
        if (FIRST) AT_STEP(pa, pb, true, lds + (J) * AT_BUF, 1, false, lds, 0, true); \
        else AT_STEP(pa, pb, true, lds + (J) * AT_BUF, 1, true, lds + (((J) + 3) & 3) * AT_BUF, 1, false); \
        if (t + 2 < NT) { if (NVP == 2) asm volatile("s_waitcnt vmcnt(3)" ::: "memory"); else asm volatile("s_waitcnt vmcnt(2)" ::: "memory"); } else asm volatile("s_waitcnt vmcnt(0)" ::: "memory"); \
        asm volatile("s_waitcnt lgkmcnt(0)" ::: "memory"); \
        __builtin_amdgcn_s_barrier(); asm volatile("" ::: "memory"); \
        if (t + 3 < NT) AT_DMA(((J) + 3) & 3); \
        if (t + 1 < NT) AT_STEP(pb, pa, true, lds + (((J) + 1) & 3) * AT_BUF, 0, true, lds + (J) * AT_BUF, 0, false); \
        else AT_STEP(pb, pa, false, lds + (((J) + 1) & 3) * AT_BUF, 0, true, lds + (J) * AT_BUF, 0, false); } while (0)
    for (int t0 = 0; t0 < NT; t0 += 4) {
        if (t0 == 0) AT_TILE(0, true); else AT_TILE(0, false);
        AT_TILE(1, false); AT_TILE(2, false); AT_TILE(3, false);
    }
#undef AT_TILE
    {
        _Pragma("unroll") for (int ks = 0; ks < 2; ++ks) { const bf16x8 pf_ = __builtin_bit_cast(bf16x8, ks == 0 ? pwp0 : pwp1);
            _Pragma("unroll") for (int db = 0; db < DB; ++db) {
                const v4i16_t lo_ = AT_VTR(lds + 3 * AT_BUF + vt_off[db] + (32 + 16 * ks) * VRB), hi_ = AT_VTR(lds + 3 * AT_BUF + vt_off[db] + (32 + 16 * ks + 8) * VRB);
                const bf16x8 vf_ = (bf16x8){lo_[0], lo_[1], lo_[2], lo_[3], hi_[0], hi_[1], hi_[2], hi_[3]};
                o[db] = __builtin_amdgcn_mfma_f32_32x32x16_bf16(vf_, pf_, o[db], 0, 0, 0); } }
    }
#undef AT_DMA
#undef AT_QF
#undef AT_VRD
#undef AT_VF
#undef AT_PVM
#undef AT_QKM
#undef AT_EXPS
#undef AT_SCALE_PK
#undef AT_GLDS
#undef AT_VTR
#undef AT_QK
#undef AT_STEP
#undef AT_STEP_OLD
#undef AT_STEP_NEW
    lsum += __shfl_xor(lsum, 32);
    const float inv = 1.f / lsum;
#pragma unroll
    for (int db = 0; db < DB; ++db)
#pragma unroll
        for (int r = 0; r < 16; ++r) o[db][r] *= inv;
    __syncthreads();
}

__device__ __forceinline__ void attn_unit_a(const bf16* PROJ, bf16* AO, int q0, int k0, int NT, int h, LAS unsigned char* lds) {
    int tid_ = threadIdx.x; asm volatile("" : "+v"(tid_));
    const int tid = tid_, lane = tid & 63, wid = tid >> 6, r32 = lane & 31, hi = lane >> 5;
    const int qr = q0 + 32 * wid + r32, g = h >> 2;
    f32x16 o[2];
    attn_pass<64>(PROJ + (size_t)qr * NP + PA_Q + 64 * h, PROJ + (size_t)k0 * NP + PA_K + 64 * g, PROJ + (size_t)k0 * NP + PA_V + 64 * g, NT, lds, o);
    bf16* orow = AO + (size_t)qr * 512 + 64 * h + 4 * hi;
#pragma unroll
    for (int db = 0; db < 2; ++db)
#pragma unroll
        for (int rg = 0; rg < 4; ++rg) *(u32x2*)(orow + 32 * db + 8 * rg) = (u32x2){cvtpk(o[db][4 * rg], o[db][4 * rg + 1]), cvtpk(o[db][4 * rg + 2], o[db][4 * rg + 3])};
}
__device__ __forceinline__ u32x2 ld_own(const bf16* p) { const unsigned long long v = __hip_atomic_load((const unsigned long long*)p, __ATOMIC_RELAXED, __HIP_MEMORY_SCOPE_AGENT); return (u32x2){(unsigned)v, (unsigned)(v >> 32)}; }
__device__ __forceinline__ void attn_unit_b(const bf16* PROJ, bf16* BO, int q0, int k0, int NT, int hh, float lam, float oscale, const float* subg, LAS unsigned char* lds) {
    int tid_ = threadIdx.x; asm volatile("" : "+v"(tid_));
    const int tid = tid_, lane = tid & 63, wid = tid >> 6, r32 = lane & 31, hi = lane >> 5;
    const int qr = q0 + 32 * wid + r32;
    bf16* orow = BO + (size_t)qr * 512 + 128 * hh + 4 * hi;
    const bf16* qp = PROJ + (size_t)qr * NP + PB_Q + 128 * hh; const bf16* kp = PROJ + (size_t)k0 * NP + PB_K + 128 * hh; const bf16* vp = PROJ + (size_t)k0 * NP + PB_V + 128 * hh;
    f32x16 o[4];
    attn_pass<128>(qp, kp, vp, NT, lds, o);
#pragma unroll
    for (int db = 0; db < 4; ++db)
#pragma unroll
        for (int rg = 0; rg < 4; ++rg) *(u32x2*)(orow + 32 * db + 8 * rg) = (u32x2){cvtpk(o[db][4 * rg], o[db][4 * rg + 1]), cvtpk(o[db][4 * rg + 2], o[db][4 * rg + 3])};
    attn_pass<128>(qp + 64, kp + 64, vp, NT, lds, o);
    asm volatile("s_waitcnt vmcnt(0)" ::: "memory");
    float ss = 0.f;
#pragma unroll
    for (int db = 0; db < 4; ++db)
#pragma unroll
        for (int rg = 0; rg < 4; ++rg) { const u32x2 w1 = ld_own(orow + 32 * db + 8 * rg);
            const float d0 = bflo(w1.x) - lam * o[db][4 * rg], d1 = bfhi(w1.x) - lam * o[db][4 * rg + 1], d2 = bflo(w1.y) - lam * o[db][4 * rg + 2], d3 = bfhi(w1.y) - lam * o[db][4 * rg + 3];
            o[db][4 * rg] = d0; o[db][4 * rg + 1] = d1; o[db][4 * rg + 2] = d2; o[db][4 * rg + 3] = d3; ss += (d0 * d0 + d1 * d1) + (d2 * d2 + d3 * d3); }
    ss += __shfl_xor(ss, 32);
    const float rstd = oscale / sqrtf(ss * (1.f / 128.f) + EPS);
#pragma unroll
    for (int db = 0; db < 4; ++db)
#pragma unroll
        for (int rg = 0; rg < 4; ++rg) { const f32x4 gq = *(const f32x4*)(subg + 32 * db + 8 * rg + 4 * hi);
            *(u32x2*)(orow + 32 * db + 8 * rg) = (u32x2){cvtpk(o[db][4 * rg] * rstd * gq[0], o[db][4 * rg + 1] * rstd * gq[1]), cvtpk(o[db][4 * rg + 2] * rstd * gq[2], o[db][4 * rg + 3] * rstd * gq[3])}; }
}

namespace ml {
constexpr int QP = 144, SP = 80;
__device__ __forceinline__ int sw2(int row) { return (row >> 2) & 7; }
constexpr int O_QS = 0, O_KS = O_QS + 64 * QP * 2, O_KT = O_KS + 64 * QP * 2, O_VT = O_KT + 128 * SP * 2, O_VW = O_VT + 48 * SP * 2, O_PS = O_VW + 48 * SP * 2,
              O_CS = O_PS + 64 * SP * 2, CS_BYTES = 48 * QP * 2, O_SC = O_CS + 2 * CS_BYTES, SC_FLOATS = 384, O_END = O_SC + 2 * SC_FLOATS * 4;
static_assert(O_END <= RING_BYTES, "mlstm lds");
}
__device__ __forceinline__ void mlstm_unit(const bf16* CQK, bf16* PROJ, const float* GS, int b, int h, int dir, int sl, LAS unsigned char* lds) {
    using namespace ml;
    int tid_ = threadIdx.x; asm volatile("" : "+v"(tid_));
    const int tid = tid_, lane = tid & 63, wid = __builtin_amdgcn_readfirstlane(tid >> 6), fr = lane & 15, fq = lane >> 4;
    const int row0 = b * SEQ;
    const int hcol = (dir == 0 ? PC_Q : PC_K) + 128 * h + 32 * sl;
    LAS bf16* Qs = (LAS bf16*)(lds + O_QS); LAS bf16* Ks = (LAS bf16*)(lds + O_KS); LAS bf16* KT = (LAS bf16*)(lds + O_KT);
    LAS bf16* VT = (LAS bf16*)(lds + O_VT); LAS bf16* VW = (LAS bf16*)(lds + O_VW); LAS bf16* Ps = (LAS bf16*)(lds + O_PS);
    for (int i = tid; i < 48 * QP / 2; i += NTHR) ((LAS unsigned*)(lds + O_CS))[i] = 0u;
    for (int i = tid; i < 16 * SP / 2; i += NTHR) { ((LAS unsigned*)(VT + 32 * SP))[i] = (i < SP / 2) ? 0x3f803f80u : 0u; ((LAS unsigned*)(VW + 32 * SP))[i] = 0u; }
    f32x4 Cacc[3];
#pragma unroll
    for (int tm = 0; tm < 3; ++tm) Cacc[tm] = (f32x4){0.f, 0.f, 0.f, 0.f};
    float m_prev = 0.f;
    const int q_t = tid >> 3, q_c = tid & 7;
    const int kv_g = (tid >> 4) & 15, kv_c = tid & 15;
    const bool is_k = tid < 256, is_v = (tid >= 256 && tid < 320);
    const int v_g = (tid - 256) >> 2, v_c = (tid - 256) & 3;
    u32x4 qreg[2], kvreg[4];
    auto chunk_base = [&](int n) -> int { return dir == 0 ? row0 + 64 * n : (n < 4 ? row0 + 64 * (3 - n) : row0 + 64 * (71 - n)); };
    auto grow = [&](int rb, int tau) -> int { return dir == 0 ? rb + tau : rb + 63 - tau; };
    auto prefetch = [&](int n) {
        const int rb = chunk_base(n);
        const bf16* qp = CQK + (size_t)grow(rb, q_t) * 1024 + 128 * h + 16 * q_c;
        qreg[0] = *(const u32x4*)qp; qreg[1] = *(const u32x4*)(qp + 8);
        if (is_k) {
#pragma unroll
            for (int j = 0; j < 4; ++j) kvreg[j] = *(const u32x4*)(CQK + (size_t)grow(rb, 4 * kv_g + j) * 1024 + 512 + 128 * h + 8 * kv_c);
        } else if (is_v) {
#pragma unroll
            for (int j = 0; j < 4; ++j) kvreg[j] = *(const u32x4*)(PROJ + (size_t)grow(rb, 4 * v_g + j) * NP + PC_V + 128 * h + 32 * sl + 8 * v_c);
        }
    };
    const float* gsp = GS + (size_t)(((b * 4 + h) * 2 + dir) * 68) * 192 + lane;
    float gu = 0.f, gm = 0.f, ga = 0.f;
    auto gload = [&](int n) { gu = gsp[(size_t)n * 192]; gm = gsp[(size_t)n * 192 + 64]; ga = gsp[(size_t)n * 192 + 128]; };
    auto scalars = [&](int n) {
        LAS float* sc = (LAS float*)(lds + O_SC) + (n & 1) * SC_FLOATS;
        const float uu = gu, a = ga;
        const float M = fmaxf(m_prev, gm);
        const float M63 = __builtin_bit_cast(float, __builtin_amdgcn_readlane(__builtin_bit_cast(int, M), 63)), a63 = __builtin_bit_cast(float, __builtin_amdgcn_readlane(__builtin_bit_cast(int, a), 63));
        sc[lane] = uu; sc[64 + lane] = M; sc[128 + lane] = __expf(m_prev - M); sc[192 + lane] = __expf(-(a + M)); sc[256 + lane] = __expf(uu - M63);
        if (lane == 0) sc[320] = __expf(m_prev - M63);
        m_prev = a63 + M63;
        if (n + 1 < 68) gload(n + 1);
    };
    auto stage = [&](int n) {
        LAS const float* sc = (LAS const float*)(lds + O_SC) + (n & 1) * SC_FLOATS;
        *(LAS u32x4*)(Qs + q_t * QP + 16 * q_c) = qreg[0]; *(LAS u32x4*)(Qs + q_t * QP + 16 * q_c + 8) = qreg[1];
        if (is_k) {
#pragma unroll
            for (int j = 0; j < 4; ++j) *(LAS u32x4*)(Ks + (4 * kv_g + j) * QP + 8 * kv_c) = kvreg[j];
#pragma unroll
            for (int i = 0; i < 8; ++i) {
                const unsigned a0 = kvreg[0][i >> 1], a1 = kvreg[1][i >> 1], a2 = kvreg[2][i >> 1], a3 = kvreg[3][i >> 1];
                unsigned lo, hi2;
                if (i & 1) { lo = __builtin_amdgcn_perm(a1, a0, 0x07060302u); hi2 = __builtin_amdgcn_perm(a3, a2, 0x07060302u); }
                else { lo = __builtin_amdgcn_perm(a1, a0, 0x05040100u); hi2 = __builtin_amdgcn_perm(a3, a2, 0x05040100u); }
                *(LAS u32x2*)(KT + (8 * kv_c + i) * SP + ((((kv_g >> 1) ^ ((kv_c >> 1) & 7)) << 3) + 4 * (kv_g & 1))) = (u32x2){lo, hi2};
            }
        } else if (is_v) {
            const float w0 = sc[256 + 4 * v_g], w1 = sc[256 + 4 * v_g + 1], w2 = sc[256 + 4 * v_g + 2], w3 = sc[256 + 4 * v_g + 3];
#pragma unroll
            for (int i = 0; i < 8; ++i) {
                const unsigned a0 = kvreg[0][i >> 1], a1 = kvreg[1][i >> 1], a2 = kvreg[2][i >> 1], a3 = kvreg[3][i >> 1];
                unsigned lo, hi2; float f0, f1, f2, f3;
                if (i & 1) { lo = __builtin_amdgcn_perm(a1, a0, 0x07060302u); hi2 = __builtin_amdgcn_perm(a3, a2, 0x07060302u); f0 = bfhi(a0); f1 = bfhi(a1); f2 = bfhi(a2); f3 = bfhi(a3); }
                else { lo = __builtin_amdgcn_perm(a1, a0, 0x05040100u); hi2 = __builtin_amdgcn_perm(a3, a2, 0x05040100u); f0 = bflo(a0); f1 = bflo(a1); f2 = bflo(a2); f3 = bflo(a3); }
                const int vcol = (((v_g >> 1) ^ sw2(8 * v_c + i)) << 3) + 4 * (v_g & 1);
                *(LAS u32x2*)(VT + (8 * v_c + i) * SP + vcol) = (u32x2){lo, hi2};
                *(LAS u32x2*)(VW + (8 * v_c + i) * SP + vcol) = (u32x2){cvtpk(f0 * w0, f1 * w1), cvtpk(f2 * w2, f3 * w3)};
            }
        } else if (tid >= 320 && tid < 384) {
            VW[32 * SP + (tid - 320)] = f2bf(sc[256 + (tid - 320)]);
        }
    };
    prefetch(0);
    if (wid == 7) { gload(0); scalars(0); }
    __syncthreads();
    stage(0);
    for (int n = 0; n < 68; ++n) {
        LAS const float* sc = (LAS const float*)(lds + O_SC) + (n & 1) * SC_FLOATS;
        LAS const bf16* Cc = (LAS const bf16*)(lds + O_CS + (n & 1) * CS_BYTES);
        LAS bf16* Cn = (LAS bf16*)(lds + O_CS + ((n + 1) & 1) * CS_BYTES);
        __syncthreads();
        if (n + 1 < 68) { prefetch(n + 1); if (wid == 7) scalars(n + 1); }
        {
            const int tr = wid >> 1, tau = 16 * tr + fr; const float Mt = sc[64 + tau]; const float decay = sc[320];
            bf16x8 qa[4], kb[2][4], va[3][2], kt[2];
#pragma unroll
            for (int kk = 0; kk < 4; ++kk) { qa[kk] = *(const LAS bf16x8*)(Qs + (16 * tr + fr) * QP + 32 * kk + 8 * fq);
#pragma unroll
                for (int tt = 0; tt < 2; ++tt) kb[tt][kk] = *(const LAS bf16x8*)(Ks + (16 * (2 * (wid & 1) + tt) + fr) * QP + 32 * kk + 8 * fq); }
#pragma unroll
            for (int kk = 0; kk < 2; ++kk) { kt[kk] = *(const LAS bf16x8*)(KT + (16 * wid + fr) * SP + (((4 * kk + fq) ^ (wid & 7)) << 3));
#pragma unroll
                for (int tm = 0; tm < 3; ++tm) va[tm][kk] = *(const LAS bf16x8*)(VW + (16 * tm + fr) * SP + (((4 * kk + fq) ^ sw2(16 * tm + fr)) << 3)); }
            f32x4 s2[2] = {(f32x4){0.f, 0.f, 0.f, 0.f}, (f32x4){0.f, 0.f, 0.f, 0.f}};
#pragma unroll
            for (int tm = 0; tm < 3; ++tm) Cacc[tm] = Cacc[tm] * decay;
#pragma unroll
            for (int kk = 0; kk < 4; ++kk) {
#pragma unroll
                for (int tt = 0; tt < 2; ++tt) s2[tt] = __builtin_amdgcn_mfma_f32_16x16x32_bf16(kb[tt][kk], qa[kk], s2[tt], 0, 0, 0);
                if (kk < 2) {
#pragma unroll
                    for (int tm = 0; tm < 3; ++tm) Cacc[tm] = __builtin_amdgcn_mfma_f32_16x16x32_bf16(kt[kk], va[tm][kk], Cacc[tm], 0, 0, 0);
                }
            }
#pragma unroll
            for (int tt = 0; tt < 2; ++tt) {
                const int tc = 2 * (wid & 1) + tt;
                const int s0 = 16 * tc + 4 * fq; const f32x4 us = *(const LAS f32x4*)(sc + s0);
                float w[4];
#pragma unroll
                for (int i = 0; i < 4; ++i) w[i] = (s0 + i <= tau) ? s2[tt][i] * __expf(us[i] - Mt) : 0.f;
                *(LAS u32x2*)(Ps + tau * SP + ((((2 * tc + (fq >> 1)) ^ sw2(tau)) << 3) + 4 * (fq & 1))) = (u32x2){cvtpk(w[0], w[1]), cvtpk(w[2], w[3])};
            }
#pragma unroll
            for (int tm = 0; tm < 3; ++tm)
                *(LAS u32x2*)(Cn + (16 * tm + fr) * QP + ((((2 * wid + (fq >> 1)) ^ sw2(16 * tm + fr)) << 3) + 4 * (fq & 1))) = (u32x2){cvtpk(Cacc[tm][0], Cacc[tm][1]), cvtpk(Cacc[tm][2], Cacc[tm][3])};
        }
        __syncthreads();
        {
            const int tr = wid >> 1, tn = wid & 1, tau = 16 * tr + fr;
            f32x4 pv = (f32x4){0.f, 0.f, 0.f, 0.f}, cq = pv, pvd = pv, cqd = pv;
#pragma unroll
            for (int kk = 0; kk < 2; ++kk) {
                const bf16x8 af = *(const LAS bf16x8*)(Ps + (16 * tr + fr) * SP + (((4 * kk + fq) ^ sw2(16 * tr + fr)) << 3));
                const bf16x8 b0 = *(const LAS bf16x8*)(VT + (16 * tn + fr) * SP + (((4 * kk + fq) ^ sw2(16 * tn + fr)) << 3));
                const bf16x8 b1 = *(const LAS bf16x8*)(VT + (32 + fr) * SP + (((4 * kk + fq) ^ sw2(32 + fr)) << 3));
                pv = __builtin_amdgcn_mfma_f32_16x16x32_bf16(b0, af, pv, 0, 0, 0);
                pvd = __builtin_amdgcn_mfma_f32_16x16x32_bf16(b1, af, pvd, 0, 0, 0);
            }
#pragma unroll
            for (int kk = 0; kk < 4; ++kk) {
                const bf16x8 af = *(const LAS bf16x8*)(Qs + (16 * tr + fr) * QP + 32 * kk + 8 * fq);
                const bf16x8 b0 = *(const LAS bf16x8*)(Cc + (16 * tn + fr) * QP + (((4 * kk + fq) ^ sw2(16 * tn + fr)) << 3));
                const bf16x8 b1 = *(const LAS bf16x8*)(Cc + (32 + fr) * QP + (((4 * kk + fq) ^ sw2(32 + fr)) << 3));
                cq = __builtin_amdgcn_mfma_f32_16x16x32_bf16(b0, af, cq, 0, 0, 0);
                cqd = __builtin_amdgcn_mfma_f32_16x16x32_bf16(b1, af, cqd, 0, 0, 0);
            }
            const int rb = chunk_base(n);
            const float ai = sc[128 + tau];
            float den = (fq == 0) ? ai * cqd[0] + pvd[0] : 0.f;
            { auto r16_ = __builtin_amdgcn_permlane16_swap(__float_as_uint(den), __float_as_uint(den), false, false); den = __uint_as_float(r16_[0]) + __uint_as_float(r16_[1]); }
            { auto r32_ = __builtin_amdgcn_permlane32_swap(__float_as_uint(den), __float_as_uint(den), false, false); den = __uint_as_float(r32_[0]) + __uint_as_float(r32_[1]); }
            const float rden = 1.f / fmaxf(fabsf(den), sc[192 + tau]);
            float hv[4];
#pragma unroll
            for (int i = 0; i < 4; ++i) hv[i] = (ai * cq[i] + pv[i]) * rden;
            *(u32x2*)(PROJ + (size_t)grow(rb, tau) * NP + hcol + 16 * tn + 4 * fq) = (u32x2){cvtpk(hv[0], hv[1]), cvtpk(hv[2], hv[3])};
        }
        __syncthreads();
        if (n + 1 < 68) stage(n + 1);
    }
    __syncthreads();
}

__device__ __forceinline__ int lane_order_k(int kp) { const int t = kp & 255; return (kp & ~255) + 128 * ((t >> 3) & 1) + 32 * (t >> 6) + 16 * ((t >> 2) & 1) + 4 * ((t >> 4) & 3) + (t & 3); }
template <bool KPERM = false>
__device__ __forceinline__ void cvt_item(const float* W, int ldw, int K, int k0, int srccol0, bf16* dst, int dstrow0, LAS float* scr, int lane) {
    f32x4 wv[8];
#pragma unroll
    for (int i = 0; i < 8; ++i) { const int kk = 8 * i + (lane >> 3); const int ks = KPERM ? lane_order_k(k0 + kk) : (k0 + kk); wv[i] = *(const f32x4*)(W + (size_t)ks * ldw + srccol0 + 4 * (lane & 7)); }
#pragma unroll
    for (int i = 0; i < 8; ++i) { const int kk = 8 * i + (lane >> 3); LAS float* d = scr + kk * 33 + 4 * (lane & 7); d[0] = wv[i][0]; d[1] = wv[i][1]; d[2] = wv[i][2]; d[3] = wv[i][3]; }
    asm volatile("s_waitcnt lgkmcnt(0)" ::: "memory");
    const int c = lane & 7;
#pragma unroll
    for (int j = 0; j < 4; ++j) { const int n = (lane >> 3) + 8 * j; const LAS float* s = scr + (8 * c) * 33 + n;
        u32x4 o; o.x = cvtpk(s[0 * 33], s[1 * 33]); o.y = cvtpk(s[2 * 33], s[3 * 33]); o.z = cvtpk(s[4 * 33], s[5 * 33]); o.w = cvtpk(s[6 * 33], s[7 * 33]);
        *(u32x4*)(dst + (size_t)(dstrow0 + n) * K + k0 + 8 * c) = o; }
    asm volatile("s_waitcnt lgkmcnt(0)" ::: "memory");
}
template <int MODE, bool KPERM = false>
__device__ __forceinline__ void cvt_matrix(const float* W, int ldw, int K, int ngroups, int off, const float* W2, bf16* dst, LAS float* scr, int gw, int ngw, int lane) {
    const int kb = K / 64, items = ngroups * kb;
    for (int it = gw; it < items; it += ngw) {
        const int gidx = it / kb, k0 = 64 * (it % kb);
        const float* src = W; int sc;
        if (MODE == 0) sc = 32 * gidx + off;
        else if (MODE == 1) { const int tile = gidx >> 3, q = gidx & 7, bj = q >> 2, wc = q & 3; sc = 64 * (4 * tile + wc) + 32 * bj; }
        else { const int tile = gidx >> 3, q = gidx & 7; sc = 128 * tile + 32 * (q & 3); if (q >= 4) src = W2; }
        cvt_item<KPERM>(src, ldw, K, k0, sc, dst, 32 * gidx, scr, lane);
    }
}

__device__ __forceinline__ void load_row(const float* p, f32x4 (&v)[4], int lane) {
#pragma unroll
    for (int j = 0; j < 4; ++j) v[j] = *(const f32x4*)(p + 4 * lane + 256 * j);
}
__device__ __forceinline__ float row_rstd(const f32x4 (&v)[4]) {
    float s = 0.f;
#pragma unroll
    for (int j = 0; j < 4; ++j) s += (v[j][0] * v[j][0] + v[j][1] * v[j][1]) + (v[j][2] * v[j][2] + v[j][3] * v[j][3]);
    return 1.0f / sqrtf(wave_sum(s) * (1.f / 1024.f) + EPS);
}
__device__ __forceinline__ void norm_mod_row(f32x4 (&v)[4], const float* g, const float* sc, const float* sh, bf16* xn, int lane) {
    const float rstd = row_rstd(v);
#pragma unroll
    for (int j = 0; j < 4; ++j) {
        const int c = 4 * lane + 256 * j;
        const f32x4 gg = *(const f32x4*)(g + c), s1 = *(const f32x4*)(sc + c), s0 = *(const f32x4*)(sh + c);
        v[j] = v[j] * rstd * gg * (s1 + 1.0f) + s0;
        *(u32x2*)(xn + c) = (u32x2){cvtpk(v[j][0], v[j][1]), cvtpk(v[j][2], v[j][3])};
    }
}
__device__ __forceinline__ void load_vec(const float* p, f32x4 (&v)[4], int lane) {
#pragma unroll
    for (int j = 0; j < 4; ++j) v[j] = *(const f32x4*)(p + 4 * lane + 256 * j);
}
__device__ __forceinline__ void norm_mod_row_pre(f32x4 (&v)[4], const f32x4 (&g)[4], const f32x4 (&sc)[4], const f32x4 (&sh)[4], bf16* xn, int lane) {
    const float rstd = row_rstd(v);
#pragma unroll
    for (int j = 0; j < 4; ++j) {
        const int c = 4 * lane + 256 * j;
        v[j] = v[j] * rstd * g[j] * (sc[j] + 1.0f) + sh[j];
        *(u32x2*)(xn + c) = (u32x2){cvtpk(v[j][0], v[j][1]), cvtpk(v[j][2], v[j][3])};
    }
}
__device__ __forceinline__ void gates_row(const f32x4 (&v)[4], LAS const float* wg, const float* gate_b, float* gout, int lane) {
    float mine = 0.f;
#pragma unroll 1
    for (int q = 0; q < 16; ++q) {
        float a = 0.f;
#pragma unroll
        for (int j = 0; j < 4; ++j) { const f32x4 w = *(const LAS f32x4*)(wg + q * 1024 + 4 * lane + 256 * j); a += (v[j][0] * w[0] + v[j][1] * w[1]) + (v[j][2] * w[2] + v[j][3] * w[3]); }
        a = wave_sum(a);
        mine = (lane == q) ? a : mine;
    }
    if (lane < 16) { const float gq = mine + gate_b[lane]; gout[lane] = ((lane >> 2) & 1) ? logsigmoidf_(gq) : gq; }
}

__device__ __forceinline__ const float* in_ptr(LAS unsigned char* lds, int i) {
    unsigned off = PTAB_OFF + 8 * i; asm volatile("" : "+s"(off));
    const unsigned long long v = *(const LAS unsigned long long*)(lds + off);
    const unsigned lo = __builtin_amdgcn_readfirstlane((unsigned)v), hi = __builtin_amdgcn_readfirstlane((unsigned)(v >> 32));
    return (const float*)(uintptr_t)(((unsigned long long)hi << 32) | lo);
}
struct Args { const float* in[34]; float* out; unsigned char* ws; int ph_lo, ph_hi; };
constexpr int PH_PER_LAYER = 13, N_PHASES = 1 + 2 * PH_PER_LAYER;

__global__ void __launch_bounds__(NTHR, 2) mk_fwd(Args args) {
    extern __shared__ __attribute__((aligned(16))) unsigned char lds_raw[];
    LAS unsigned char* lds = (LAS unsigned char*)lds_raw;
    int tid = threadIdx.x, lane = tid & 63, wave = __builtin_amdgcn_readfirstlane(tid >> 6);
    const int G = gridDim.x, bid = blockIdx.x, ngw = G * NWAVES; int gw = bid * NWAVES + wave;
#define REFRESH() do { tid = threadIdx.x; asm volatile("" : "+v"(tid)); lane = tid & 63; wave = __builtin_amdgcn_readfirstlane(tid >> 6); gw = bid * NWAVES + wave; scr = (LAS float*)(lds + wave * 16384); } while (0)
    unsigned char* ws = args.ws;
    unsigned* ctl = (unsigned*)(ws + WS_CTL);
    volatile LAS unsigned* MISC = (volatile LAS unsigned*)(lds + MISC_OFF);
    for (int u = tid; u < (LDS_BYTES - RING_BYTES) / 4; u += NTHR) ((LAS unsigned*)(lds + RING_BYTES))[u] = 0u;
    if (tid == 0) {
#pragma unroll
        for (int i = 0; i < 34; ++i) ((LAS unsigned long long*)(lds + PTAB_OFF))[i] = (unsigned long long)(uintptr_t)args.in[i];
    }
    __syncthreads();
    const int lo = args.ph_lo, hi = args.ph_hi;
    if (hi - lo > 1) (void)xcd_barrier_post(ctl + CW_BAR, MISC + 8);
#define IN(k) (lo <= (k) && (k) < hi)
#ifndef PHM
#define PHM 0xffff
#endif
#define INJ(j) (((PHM >> (j)) & 1) && IN(pb + (j)))
#define SEAM(k) do { if (IN(k) && IN((k) + 1)) { XcdBarrier b_; b_.bar = (unsigned*)(args.ws + WS_CTL) + CW_BAR; b_.x = xb_xcc_id(); b_.st = (volatile LAS unsigned*)(lds + MISC_OFF) + 8; xcd_barrier(b_); } } while (0)

#define x_in in_ptr(lds, 0)
#define c_in in_ptr(lds, 1)
#define ctx_in in_ptr(lds, 2)
#define cctx_in in_ptr(lds, 3)
    float* MOD = (float*)(ws + WS_MOD); float* ROPEC = (float*)(ws + WS_ROPE); float* ROPES = ROPEC + 1024;
    float* GATES = (float*)(ws + WS_GATES); float* CTXRES = (float*)(ws + WS_CTXRES);
    bf16* XN = (bf16*)(ws + WS_R0); bf16* CQK = (bf16*)(ws + WS_CQK); bf16* PROJ = (bf16*)(ws + WS_R1);
    bf16* AO = (bf16*)(ws + WS_AO); bf16* BO = (bf16*)(ws + WS_BO); bf16* MO = (bf16*)(ws + WS_MO);
    bf16* GB = (bf16*)(ws + WS_G); bf16* UB = (bf16*)(ws + WS_U); bf16* Y = (bf16*)(ws + WS_Y); bf16* HB = (bf16*)(ws + WS_H); bf16* Y2 = (bf16*)(ws + WS_Y2);
    LAS float* scr = (LAS float*)(lds + wave * 16384);

    for (int rep0_ = 0; rep0_ < ((((PROBE_DUP) >> 15) & 1) ? 2 : 1); ++rep0_)
    if (IN(0)) {
        REFRESH();
        LAS float* sl = (LAS float*)lds;
        for (int i = tid; i < 9 * 1024; i += NTHR) { const int j = i >> 10, k = i & 1023; const float cv = j < 8 ? c_in[j * 1024 + k] : cctx_in[k]; sl[i] = siluf_(cv); }
        __syncthreads();
        LAS float* red = (LAS float*)(lds + 40960);
        for (int un = bid; un < 192; un += G) {
            const int l = un / 96, n0 = 64 * (un % 96), ks = tid >> 6, col = tid & 63;
            const float* w = in_ptr(lds, 4) + (size_t)l * 1024 * 6144 + n0 + col;
            float a[9];
#pragma unroll
            for (int j = 0; j < 9; ++j) a[j] = 0.f;
            for (int k = ks * 128; k < ks * 128 + 128; ++k) { const float wv = w[(size_t)k * 6144];
#pragma unroll
                for (int j = 0; j < 9; ++j) a[j] += sl[j * 1024 + k] * wv; }
#pragma unroll
            for (int j = 0; j < 9; ++j) red[(ks * 9 + j) * 64 + col] = a[j];
            __syncthreads();
            for (int i = tid; i < 9 * 64; i += NTHR) { const int j = i >> 6, cc = i & 63; float s = 0.f;
#pragma unroll
                for (int k2 = 0; k2 < 8; ++k2) s += red[(k2 * 9 + j) * 64 + cc];
                MOD[((size_t)l * 9 + j) * 6144 + n0 + cc] = s + in_ptr(lds, 5)[l * 6144 + n0 + cc]; }
            __syncthreads();
        }
        if (bid == (G > 200 ? 200 : 0)) {
            for (int i = tid; i < 1024; i += NTHR) { const int p = i >> 4, f = i & 15; const float inv = powf(10000.f, -(float)f / 16.f); const float ang = (float)p * inv; float s, c; sincosf(ang, &s, &c); ROPEC[i] = c; ROPES[i] = s; }
        }
        __syncthreads();
    }
    SEAM(0);

    for (int l = 0; l < 2; ++l) {
        const int pb = 1 + PH_PER_LAYER * l;
        const bool last = (l == 1);
        const float* modl = MOD + (size_t)l * 9 * 6144;
        const float* win = in_ptr(lds, 10) + (size_t)l * D * NIN;
        const float* xres_lat = (l == 0) ? x_in : args.out;
        const float* xres_ctx = (l == 0) ? ctx_in : CTXRES;
        const float lam_init = (l == 0) ? 0.2f : (0.8f - 0.6f * 0.7408182206817179f);

#define CVT_MIXER(LL) do { const float* win_ = in_ptr(lds, 10) + (size_t)(LL) * D * NIN; const float* wa_ = in_ptr(lds, 22) + (size_t)(LL) * 512 * 1024; \
            const float* wb_ = in_ptr(lds, 23) + (size_t)(LL) * 512 * 1024; const float* wc_ = in_ptr(lds, 24) + (size_t)(LL) * 512 * 1024; const float* wo_ = in_ptr(lds, 25) + (size_t)(LL) * 1024 * 1024; \
            constexpr int J_IN = (NP / 32) * 16, J_G = (3072 / 32) * 16, J_BR = 32 * 8, J_O = 32 * 16; \
            for (int it = gw; it < J_IN + J_G + 3 * J_BR + J_O; it += ngw) { int r = it; \
                if (r < J_IN) { const int gidx = r >> 4, k0 = 64 * (r & 15), tile = gidx >> 3, q = gidx & 7; cvt_item(win_, NIN, D, k0, 64 * (4 * tile + (q & 3)) + 32 * (q >> 2), (bf16*)(ws + W_IN), 32 * gidx, scr, lane); continue; } r -= J_IN; \
                if (r < J_G) { const int gidx = r >> 4, k0 = 64 * (r & 15); cvt_item(win_, NIN, D, k0, 4368 + 32 * gidx, (bf16*)(ws + W_G), 32 * gidx, scr, lane); continue; } r -= J_G; \
                if (r < 3 * J_BR) { const int br = r / J_BR, q = r - br * J_BR, gidx = q >> 3, k0 = 64 * (q & 7); cvt_item(br == 0 ? wa_ : (br == 1 ? wb_ : wc_), 1024, 512, k0, 32 * gidx, (bf16*)(ws + W_A) + (size_t)br * 512 * 1024, 32 * gidx, scr, lane); continue; } r -= 3 * J_BR; \
                { const int gidx = r >> 4, k0 = 64 * (r & 15); cvt_item<true>(wo_, 1024, 1024, k0, 32 * gidx, (bf16*)(ws + W_O), 32 * gidx, scr, lane); } } } while (0)
        REP(0) if (INJ(0) && l == 0) {
            REFRESH();
            CVT_MIXER(0);
            __syncthreads();
            LAS float* wg = (LAS float*)lds;
            for (int i = tid; i < 16 * 1024; i += NTHR) { const int k = i >> 4, q = i & 15; wg[q * 1024 + k] = win[(size_t)k * NIN + 4352 + q]; }
            __syncthreads();
            const float* xin_p = x_in; const float* cin_p = ctx_in; const float* pmg_h = in_ptr(lds, 6) + l * D; const float* gbp_h = in_ptr(lds, 20) + l * 16;
            for (int r = gw; r < R; r += ngw) {
                const int b = r / SEQ, pos = r % SEQ; const bool isc = pos < NCTX;
                const float* xr = isc ? cin_p + ((size_t)b * NCTX + pos) * D : xin_p + ((size_t)b * TLAT + pos - NCTX) * D;
                const float* md = modl + (size_t)(isc ? 8 : b) * 6144;
                f32x4 v[4], mgv[4], scv[4], shv[4]; load_row(xr, v, lane); load_vec(pmg_h, mgv, lane); load_vec(md + 1024, scv, lane); load_vec(md, shv, lane);
                norm_mod_row_pre(v, mgv, scv, shv, XN + (size_t)r * D, lane);
                gates_row(v, wg, gbp_h, GATES + (size_t)r * 16, lane);
            }
            __syncthreads();
        }
        if (l == 0) SEAM(pb + 0);

        REP(1) if (INJ(1)) {
            REFRESH();
            pg8::GemmP g{D, D, D}; InProjOrder S; S.G = G; S.c = bid; S.skip = last ? 1 : 0; S.A = (const char*)XN; S.B = (const char*)(ws + W_IN);
            LAS float* etab = (LAS float*)(lds + RING_BYTES + 4096);
            { const float* qgp = in_ptr(lds, 11) + l * 64; const float* kgp = in_ptr(lds, 12) + l * 64;
              for (int i = tid; i < 2176; i += NTHR) etab[i] = i < 2048 ? ROPEC[i] : (i < 2112 ? qgp[i - 2048] : kgp[i - 2112]); }
            __syncthreads();
            EpiInProj E{PROJ, etab + 2048, etab + 2112, etab, etab + 1024};
            pg8::gemm_phase(lds, g, S, E);
        }
        SEAM(pb + 1);

        REP(2) if (INJ(2)) {
            REFRESH();
            const int c8 = tid & 127, rsub = tid >> 7;
            const float* cw = in_ptr(lds, 18) + (size_t)l * 3 * 1024 + 8 * c8; const float* cb = in_ptr(lds, 19) + (size_t)l * 1024 + 8 * c8;
            float w0[8], w1[8], w2[8], bb[8];
#pragma unroll
            for (int i = 0; i < 8; ++i) { w0[i] = cw[i]; w1[i] = cw[1024 + i]; w2[i] = cw[2048 + i]; bb[i] = cb[i]; }
            const float ksc = c8 >= 64 ? 0.08838834764831845f : 1.f;
            const int nwk = G * 4, rpw = (R + nwk - 1) / nwk, r0 = (bid * 4 + rsub) * rpw, r1 = (r0 + rpw < R) ? r0 + rpw : R;
            for (int r = r0; r < r1; r += 4) {
                u32x4 xw[6];
#pragma unroll
                for (int k = 0; k < 6; ++k) { const int rr = r - 1 + k; const bool ok = (rr >= 0 && rr < R); const int rc = ok ? rr : r;
                    xw[k] = *(const u32x4*)(PROJ + (size_t)rc * NP + PC_Q + 8 * c8); if (!ok) xw[k] = (u32x4){0u, 0u, 0u, 0u}; }
#pragma unroll
                for (int k = 0; k < 4; ++k) { const int row = r + k;
                    if (row < r1) {
                        const int pos = row % SEQ;
                        const bool hasl = !(pos == 0 || pos == NCTX), hasr = !(pos == NCTX - 1 || pos == SEQ - 1);
                        const u32x4 z4 = (u32x4){0u, 0u, 0u, 0u};
                        const u32x4 xl = hasl ? xw[k] : z4, xc = xw[k + 1], xr = hasr ? xw[k + 2] : z4;
                        float o[8];
#pragma unroll
                        for (int i = 0; i < 8; ++i) {
                            const float a = (i & 1) ? bfhi(xl[i >> 1]) : bflo(xl[i >> 1]), bq = (i & 1) ? bfhi(xc[i >> 1]) : bflo(xc[i >> 1]), cq = (i & 1) ? bfhi(xr[i >> 1]) : bflo(xr[i >> 1]);
                            o[i] = siluf_(a * w0[i] + bq * w1[i] + cq * w2[i] + bb[i]) * ksc;
                        }
                        *(u32x4*)(CQK + (size_t)row * 1024 + 8 * c8) = (u32x4){cvtpk(o[0], o[1]), cvtpk(o[2], o[3]), cvtpk(o[4], o[5]), cvtpk(o[6], o[7])};
                    } }
            }
        }
        if (INJ(2)) {
            float* GSw = (float*)(ws + WS_MO);
            for (int task = gw; task < NB * 4 * 2 * 68; task += ngw) {
                const int n = task % 68, chain = task / 68, dir = chain & 1, h = (chain >> 1) & 3, b = chain >> 3;
                const int row0 = b * SEQ;
                const int rb = dir == 0 ? row0 + 64 * n : (n < 4 ? row0 + 64 * (3 - n) : row0 + 64 * (71 - n));
                const int row = dir == 0 ? rb + lane : rb + 63 - lane;
                const float* gp = GATES + (size_t)row * 16 + (dir == 0 ? 0 : 8) + h;
                const float ig = gp[0], lf = gp[4];
                float a = lf;
#pragma unroll
                for (int o = 1; o < 64; o <<= 1) { const float t = __shfl_up(a, o); if (lane >= o) a += t; }
                const float uu = ig - a;
                float mloc = uu;
#pragma unroll
                for (int o = 1; o < 64; o <<= 1) { const float t = __shfl_up(mloc, o); if (lane >= o) mloc = fmaxf(mloc, t); }
                float* o3 = GSw + (size_t)task * 192 + lane;
                o3[0] = uu; o3[64] = mloc; o3[128] = a;
            }
        }
        SEAM(pb + 2);

        REP(3) if (INJ(3)) {
            REFRESH();
            const bool x8 = (G == 256);
            const int vcu = x8 ? (bid & 7) * 32 + (bid >> 3) : bid;
#ifndef NO_MLSTM
            for (int rp_ = 0; rp_ < PROBE_ML; ++rp_)
            for (int id = vcu; id < 256; id += G) { const int chain = id >> 2; mlstm_unit(CQK, PROJ, (const float*)(ws + WS_MO), chain >> 3, (chain >> 1) & 3, chain & 1, id & 3, lds); }
#endif
            if (IN(pb + 3)) { XcdBarrier b_; b_.bar = (unsigned*)(args.ws + WS_CTL) + CW_BAR; b_.x = xb_xcc_id(); b_.st = (volatile LAS unsigned*)(lds + MISC_OFF) + 8; xcd_barrier(b_); }
            REFRESH();
            {
            const float* ng = in_ptr(lds, 21) + l * 128;
            for (int r = gw; r < R; r += ngw) {
                const bf16* pr = PROJ + (size_t)r * NP;
                const u32x4 hf = *(const u32x4*)(pr + PC_Q + 8 * lane), hb = *(const u32x4*)(pr + PC_K + 8 * lane), op = *(const u32x4*)(pr + PC_O + 8 * lane);
                float hs[8]; float ss = 0.f;
#pragma unroll
                for (int i = 0; i < 8; ++i) { hs[i] = ((i & 1) ? bfhi(hf[i >> 1]) : bflo(hf[i >> 1])) + ((i & 1) ? bfhi(hb[i >> 1]) : bflo(hb[i >> 1])); ss += hs[i] * hs[i]; }
                ss = row16_sum(ss);
                const float rstd = 1.0f / sqrtf(ss * (1.f / 128.f) + EPS);
                float o[8];
#pragma unroll
                for (int i = 0; i < 8; ++i) { const float og = (i & 1) ? bfhi(op[i >> 1]) : bflo(op[i >> 1]); o[i] = hs[i] * rstd * ng[(8 * lane + i) & 127] * sigmoidf_(og); }
                *(u32x4*)(MO + (size_t)r * 512 + 8 * lane) = (u32x4){cvtpk(o[0], o[1]), cvtpk(o[2], o[3]), cvtpk(o[4], o[5]), cvtpk(o[6], o[7])};
            }
            }
            float lam;
            { const float p1 = wave_sum(in_ptr(lds, 13)[l * 64 + lane] * in_ptr(lds, 14)[l * 64 + lane]), p2 = wave_sum(in_ptr(lds, 15)[l * 64 + lane] * in_ptr(lds, 16)[l * 64 + lane]); lam = __expf(p1) - __expf(p2) + lam_init; }
            const float* subg = in_ptr(lds, 17) + l * 128;
            for (int k = 0, id = vcu; id < 512; id += G, ++k) { int b = id >> 6, hh = (id >> 4) & 3, qb = id & 15;
                if (x8) { const int grp = 4 * (vcu >> 5) + (k >> 0) * 2 + ((vcu & 31) >> 4); b = grp >> 2; hh = grp & 3; qb = vcu & 15; }
#ifndef NO_ATTNB
                attn_unit_b(PROJ, BO, b * SEQ + NCTX + 256 * qb, b * SEQ, 68, hh, lam, 1.f - lam_init, subg, lds);
#endif
 }
            for (int k = 0, id = vcu; id < 1024; id += G, ++k) { int b = id >> 7, h = (id >> 4) & 7, qb = id & 15;
                if (x8) { const int grp = 2 * (vcu >> 5) + (k >> 1), u = (vcu & 31) + 32 * (k & 1); b = grp >> 1; h = 4 * (grp & 1) + (u >> 4); qb = u & 15; }
#ifndef NO_ATTNA
                attn_unit_a(PROJ, AO, b * SEQ + NCTX + 256 * qb, b * SEQ, 68, h, lds);
#endif
 }
            if (!last) {
                for (int id = bid; id < 96; id += G) {
#ifndef NO_ATTNC
                    if (id < 64) attn_unit_a(PROJ, AO, (id >> 3) * SEQ, (id >> 3) * SEQ, 4, id & 7, lds);
                    else { const int j = id - 64; attn_unit_b(PROJ, BO, (j >> 2) * SEQ, (j >> 2) * SEQ, 4, j & 3, lam, 1.f - lam_init, subg, lds); }
#endif
                }
            }
        }
        SEAM(pb + 3);


        REP(5) if (INJ(5)) {
            REFRESH();
            pg8::GemmP g{D, D, D}; pg8::StaticOrder S; S.init(R, 3072, G, bid, XN, D, ws + W_G, D, last ? 1 : 0);
            EpiSigmoid E{GB, 3072};
            pg8::gemm_phase(lds, g, S, E);
        }
        SEAM(pb + 5);

        REP(6) if (INJ(6)) {
            REFRESH();
            pg8::GemmP g{512, 512, 512}; MergeOrder S; S.lat = last ? 1 : 0; S.nM = last ? 128 : R / 256; S.nN = 4; S.nwg = S.nM * 4; S.G = G; S.c = bid;
            S.A0 = (const char*)AO; S.B0 = (const char*)(ws + W_A);
            EpiMerge E{GB, UB};
            pg8::gemm_phase(lds, g, S, E);
        }
        SEAM(pb + 6);

        REP(7) if (INJ(7)) {
            REFRESH();
            pg8::GemmP g{D, D, D}; pg8::StaticOrder S; S.init(R, D, G, bid, UB, D, ws + W_O, D, last ? 1 : 0);
            EpiBf16 E{Y, D};
            pg8::gemm_phase(lds, g, S, E);
            if (!last && bid >= 32) {
                REFRESH();
                const int cw = (bid - 32) * NWAVES + wave, ncw = (G - 32) * NWAVES;
                const float* wgp = in_ptr(lds, 26); const float* wup = in_ptr(lds, 27); const float* wdp = in_ptr(lds, 28);
                constexpr int I_GU = (2 * DFF / 32) * (D / 64), I_D = (D / 32) * (DFF / 64);
                for (int it = cw; it < I_GU + I_D; it += ncw) { int r = it;
                    if (r < I_GU) { const int gidx = r / (D / 64), k0 = 64 * (r % (D / 64)), tile = gidx >> 3, q = gidx & 7;
                        cvt_item((q >= 4 ? wup : wgp), DFF, D, k0, 128 * tile + 32 * (q & 3), (bf16*)(ws + WFF_GU), 32 * gidx, scr, lane); }
                    else { r -= I_GU; const int gidx = r / (DFF / 64), k0 = 64 * (r % (DFF / 64)); cvt_item(wdp, D, DFF, k0, 32 * gidx, (bf16*)(ws + WFF_D), 32 * gidx, scr, lane); } }
            }
        }
        SEAM(pb + 7);

        for (int rep_ = 0; rep_ < ((((PROBE_DUP) >> 8) & 1) && !last ? 2 : 1); ++rep_) if (INJ(8)) {
            REFRESH();
            LAS float* wrl = (LAS float*)lds;
            if (last) { for (int i = tid; i < 8 * 1024; i += NTHR) { const int k = i >> 3, e = i & 7; wrl[e * 1024 + k] = in_ptr(lds, 29)[(size_t)k * 8 + e]; } __syncthreads(); }
            int* TOKE = (int*)(ws + MOE_TOKE); int* TOKP = (int*)(ws + MOE_TOKP); float* TOKW = (float*)(ws + MOE_TOKW);
            int wcn[8] = {0, 0, 0, 0, 0, 0, 0, 0}; int nrw = 0, sv_t = 0, sv_e = 0, sv_p = 0; float sv_w = 0.f;
            const float* pog_h = in_ptr(lds, 7) + l * D; const float* pfg_h = in_ptr(lds, 8) + l * D; const float* brp_h = in_ptr(lds, 30);
            for (int r = gw; r < R; r += ngw) {
                const int b = r / SEQ, pos = r % SEQ; const bool isc = pos < NCTX;
                if (isc && last) continue;
                const float* xr = isc ? xres_ctx + ((size_t)b * NCTX + pos) * D : xres_lat + ((size_t)b * TLAT + pos - NCTX) * D;
                float* xo = isc ? CTXRES + ((size_t)b * NCTX + pos) * D : args.out + ((size_t)b * TLAT + pos - NCTX) * D;
                const float* md = modl + (size_t)(isc ? 8 : b) * 6144;
                f32x4 y[4], v[4], pgv[4], g1v[4], fgv[4], scv[4], shv[4];
                { u32x2 yb[4];
#pragma unroll
                  for (int j = 0; j < 4; ++j) yb[j] = *(const u32x2*)(Y + (size_t)r * D + 4 * lane + 256 * j);
#pragma unroll
                  for (int j = 0; j < 4; ++j) y[j] = (f32x4){bflo(yb[j].x), bfhi(yb[j].x), bflo(yb[j].y), bfhi(yb[j].y)}; }
                load_row(xr, v, lane); load_vec(pog_h, pgv, lane); load_vec(md + 2048, g1v, lane); load_vec(pfg_h, fgv, lane); load_vec(md + 4096, scv, lane); load_vec(md + 3072, shv, lane);
                const float rstd = row_rstd(y);
#pragma unroll
                for (int j = 0; j < 4; ++j) { const int c = 4 * lane + 256 * j;
                    v[j] = v[j] + g1v[j] * (y[j] * rstd * pgv[j]); *(f32x4*)(xo + c) = v[j]; }
                norm_mod_row_pre(v, fgv, scv, shv, XN + (size_t)r * D, lane);
                if (last) {
                    float lg[8];
#pragma unroll
                    for (int e = 0; e < 8; ++e) { float a = 0.f;
#pragma unroll
                        for (int j = 0; j < 4; ++j) { const f32x4 w = *(const LAS f32x4*)(wrl + e * 1024 + 4 * lane + 256 * j); a += (v[j][0] * w[0] + v[j][1] * w[1]) + (v[j][2] * w[2] + v[j][3] * w[3]); }
                        lg[e] = wave_sum(a) + brp_h[e]; }
                    int e0 = 0; float v0 = lg[0];
#pragma unroll
                    for (int e = 1; e < 8; ++e) if (lg[e] > v0) { v0 = lg[e]; e0 = e; }
                    int e1 = -1; float v1 = -INFINITY;
#pragma unroll
                    for (int e = 0; e < 8; ++e) if (e != e0 && lg[e] > v1) { v1 = lg[e]; e1 = e; }
                    const float w1 = 1.f / (1.f + __expf(v0 - v1)), w0 = 1.f - w1;
                    int lp0 = 0, lp1 = 0;
#pragma unroll
                    for (int e = 0; e < 8; ++e) { if (e == e0) { lp0 = wcn[e]; wcn[e] += 1; } if (e == e1) { lp1 = wcn[e]; wcn[e] += 1; } }
                    if (lane == nrw) { sv_t = b * TLAT + pos - NCTX; sv_e = e0 | (e1 << 8); sv_p = lp0 | (lp1 << 16); sv_w = w0; }
                    ++nrw;
                }
            }
            if (last) {
                LAS int* wcl = (LAS int*)(lds + 65536);
                int mycnt = 0;
#pragma unroll
                for (int e = 0; e < 8; ++e) mycnt = (lane == e) ? wcn[e] : mycnt;
                if (lane < 8) wcl[wave * 8 + lane] = mycnt;
                __syncthreads();
                if (wave == 0 && lane < 8) { int tot = 0;
#pragma unroll
                    for (int w = 0; w < 8; ++w) tot += wcl[w * 8 + lane];
                    int base = (int)atomicAdd(ctl + CW_CNT + 64 * lane, (unsigned)tot);
#pragma unroll
                    for (int w = 0; w < 8; ++w) { const int c = wcl[w * 8 + lane]; wcl[64 + w * 8 + lane] = base; base += c; } }
                __syncthreads();
                if (lane < nrw) { const int e0 = sv_e & 255, e1 = sv_e >> 8;
                    TOKE[2 * sv_t] = e0; TOKE[2 * sv_t + 1] = e1; TOKP[2 * sv_t] = wcl[64 + wave * 8 + e0] + (sv_p & 0xffff); TOKP[2 * sv_t + 1] = wcl[64 + wave * 8 + e1] + (sv_p >> 16);
                    TOKW[2 * sv_t] = sv_w; TOKW[2 * sv_t + 1] = 1.f - sv_w; }
            }
            __syncthreads();
        }
        SEAM(pb + 8);

        if (!last) {
            REP(9) if (INJ(9)) {
            REFRESH();
                pg8::GemmP g{D, D, D}; pg8::StaticOrder S; S.init(R, 2 * DFF, G, bid, XN, D, ws + WFF_GU, D);
                EpiSwiGLU E{HB, DFF};
                pg8::gemm_phase(lds, g, S, E);
            }
            SEAM(pb + 9);
            REP(10) if (INJ(10)) {
            REFRESH();
                pg8::GemmP g{DFF, DFF, DFF}; pg8::StaticOrder S; S.init(R, D, G, bid, HB, DFF, ws + WFF_D, DFF);
                EpiBf16 E{Y2, D};
                pg8::gemm_phase(lds, g, S, E);
            }
            SEAM(pb + 10);
            if (INJ(11)) {
            REFRESH();
                CVT_MIXER(1);
                __syncthreads();
                const float* win1 = in_ptr(lds, 10) + (size_t)D * NIN;
                const float* mod1 = MOD + (size_t)9 * 6144;
                LAS float* wg = (LAS float*)lds;
                for (int i = tid; i < 16 * 1024; i += NTHR) { const int k = i >> 4, q = i & 15; wg[q * 1024 + k] = win1[(size_t)k * NIN + 4352 + q]; }
                __syncthreads();
                const float* pfg_h = in_ptr(lds, 9) + l * D; const float* pmg1_h = in_ptr(lds, 6) + D; const float* gbp1_h = in_ptr(lds, 20) + 16;
                for (int r = gw; r < R; r += ngw) {
                    const int b = r / SEQ, pos = r % SEQ; const bool isc = pos < NCTX;
                    float* xo = isc ? CTXRES + ((size_t)b * NCTX + pos) * D : args.out + ((size_t)b * TLAT + pos - NCTX) * D;
                    const float* md = modl + (size_t)(isc ? 8 : b) * 6144;
                    const float* md1 = mod1 + (size_t)(isc ? 8 : b) * 6144;
                    f32x4 y[4], v[4], pgv[4], g2v[4], mgv[4], scv[4], shv[4]; load_row(xo, v, lane);
                    load_vec(pfg_h, pgv, lane); load_vec(md + 5120, g2v, lane); load_vec(pmg1_h, mgv, lane); load_vec(md1 + 1024, scv, lane); load_vec(md1, shv, lane);
#pragma unroll
                    for (int j = 0; j < 4; ++j) { const u32x2 a = *(const u32x2*)(Y2 + (size_t)r * D + 4 * lane + 256 * j); y[j] = (f32x4){bflo(a.x), bfhi(a.x), bflo(a.y), bfhi(a.y)}; }
                    const float rstd = row_rstd(y);
#pragma unroll
                    for (int j = 0; j < 4; ++j) { const int c = 4 * lane + 256 * j;
                        v[j] = v[j] + g2v[j] * (y[j] * rstd * pgv[j]); *(f32x4*)(xo + c) = v[j]; }
                    norm_mod_row_pre(v, mgv, scv, shv, XN + (size_t)r * D, lane);
                    gates_row(v, wg, gbp1_h, GATES + (size_t)r * 16, lane);
                }
                __syncthreads();
            }
            SEAM(pb + 11);
        } else {
            int* TOKE = (int*)(ws + MOE_TOKE); int* TOKP = (int*)(ws + MOE_TOKP); float* TOKW = (float*)(ws + MOE_TOKW);
            int* ROWSLOT = (int*)(ws + MOE_ROWSLOT); float* ROWW = (float*)(ws + MOE_ROWW);
            bf16* XG = (bf16*)(ws + WS_XG); bf16* HM = (bf16*)(ws + WS_HM); bf16* YS = (bf16*)(ws + WS_YS);
            REP(9) if (INJ(9)) {
            REFRESH();
                int tb[NEXP + 1], cnt[NEXP]; tb[0] = 0;
#pragma unroll
                for (int e = 0; e < NEXP; ++e) { cnt[e] = (int)__hip_atomic_load(ctl + CW_CNT + 64 * e, __ATOMIC_RELAXED, __HIP_MEMORY_SCOPE_AGENT); tb[e + 1] = tb[e] + (cnt[e] + 255) / 256; }
                for (int pr0 = gw * 4; pr0 < 2 * NB * TLAT; pr0 += ngw * 4) {
                    int rowq[4]; u32x4 va[4], vb[4];
#pragma unroll
                    for (int q = 0; q < 4; ++q) { const int pr = pr0 + q; const int e = TOKE[pr] & 7, p = TOKP[pr] & 0x7fff;
                        int base = 0;
#pragma unroll
                        for (int j = 0; j < NEXP; ++j) base = (j == e) ? tb[j] : base;
                        rowq[q] = min(base * 256 + p, XG_ROWS - 1); }
#pragma unroll
                    for (int q = 0; q < 4; ++q) { const int t = (pr0 + q) >> 1; const int b = t / TLAT, tt = t % TLAT; const size_t srow = (size_t)b * SEQ + NCTX + tt;
                        const u32x4* src = (const u32x4*)(XN + srow * D); va[q] = src[lane]; vb[q] = src[lane + 64]; }
#pragma unroll
                    for (int q = 0; q < 4; ++q) { u32x4* dst = (u32x4*)(XG + (size_t)rowq[q] * D); dst[lane] = va[q]; dst[lane + 64] = vb[q];
                        if (lane == 0) { ROWSLOT[rowq[q]] = pr0 + q; ROWW[rowq[q]] = TOKW[pr0 + q]; } }
                }
#pragma unroll
                for (int e = 0; e < NEXP; ++e) {
                    const int r0 = tb[e] * 256 + cnt[e], r1 = tb[e + 1] * 256;
                    for (int row = r0 + gw; row < r1; row += ngw) { u32x4* dst = (u32x4*)(XG + (size_t)row * D); unsigned z0 = 0u; asm volatile("" : "+v"(z0)); const u32x4 zz = (u32x4){z0, z0, z0, z0}; dst[lane] = zz; dst[lane + 64] = zz; if (lane == 0) { ROWSLOT[row] = -1; ROWW[row] = 0.f; } }
                }
                {
                    const float* wgp = in_ptr(lds, 31); const float* wup = in_ptr(lds, 32); const float* wdp = in_ptr(lds, 33);
                    constexpr int I_GU = (2 * DFE / 32) * (D / 64), I_D = (D / 32) * (DFE / 64), I_E = I_GU + I_D;
                    for (int it = gw; it < NEXP * I_E; it += ngw) {
                        const int e = it / I_E; int r = it - e * I_E;
                        if (r < I_GU) { const int gidx = r / (D / 64), k0 = 64 * (r % (D / 64)), tile = gidx >> 3, q = gidx & 7;
                            cvt_item((q >= 4 ? wup : wgp) + (size_t)e * D * DFE, DFE, D, k0, 128 * tile + 32 * (q & 3), (bf16*)(ws + WM_GU) + (size_t)e * 2 * DFE * D, 32 * gidx, scr, lane); }
                        else { r -= I_GU; const int gidx = r / (DFE / 64), k0 = 64 * (r % (DFE / 64));
                            cvt_item(wdp + (size_t)e * DFE * D, D, DFE, k0, 32 * gidx, (bf16*)(ws + WM_D) + (size_t)e * D * DFE, 32 * gidx, scr, lane); }
                    }
                }
                __syncthreads();
            }
            SEAM(pb + 9);
            REP(10) if (INJ(10)) {
            REFRESH();
                pg8::GemmP g{D, D, D}; MoeOrder S; S.tb[0] = 0;
#pragma unroll
                for (int e = 0; e < NEXP; ++e) { const int c = (int)__hip_atomic_load(ctl + CW_CNT + 64 * e, __ATOMIC_RELAXED, __HIP_MEMORY_SCOPE_AGENT); S.tb[e + 1] = S.tb[e] + (c + 255) / 256; }
                S.nN = 2 * DFE / 256; S.G = G; S.c = bid; S.A = (const char*)XG; S.B = (const char*)(ws + WM_GU); S.ta = (size_t)256 * D * 2; S.tb_tile = (size_t)256 * D * 2; S.tb_exp = (size_t)2 * DFE * D * 2;
                EpiSwiGLU E{HM, DFE};
                pg8::gemm_phase(lds, g, S, E);
            }
            SEAM(pb + 10);
            REP(11) if (INJ(11)) {
            REFRESH();
                pg8::GemmP g{DFE, DFE, DFE}; MoeOrder S; S.tb[0] = 0;
#pragma unroll
                for (int e = 0; e < NEXP; ++e) { const int c = (int)__hip_atomic_load(ctl + CW_CNT + 64 * e, __ATOMIC_RELAXED, __HIP_MEMORY_SCOPE_AGENT); S.tb[e + 1] = S.tb[e] + (c + 255) / 256; }
                S.nN = 4; S.G = G; S.c = bid; S.A = (const char*)HM; S.B = (const char*)(ws + WM_D); S.ta = (size_t)256 * DFE * 2; S.tb_tile = (size_t)256 * DFE * 2; S.tb_exp = (size_t)D * DFE * 2;
                EpiMoeDown E{YS, ROWSLOT, ROWW};
                pg8::gemm_phase(lds, g, S, E);
            }
            SEAM(pb + 11);
            REP(12) if (INJ(12)) {
            REFRESH();
                const float* pfg_h = in_ptr(lds, 9) + l * D;
                f32x4 pgv[4]; load_vec(pfg_h, pgv, lane);
                for (int t0 = gw; t0 < NB * TLAT; t0 += 2 * ngw) {
                    const int t1 = t0 + ngw; const bool h1 = t1 < NB * TLAT; const int t1c = h1 ? t1 : t0;
                    float* xo0 = args.out + (size_t)t0 * D; float* xo1 = args.out + (size_t)t1c * D;
                    f32x4 v0[4], v1[4], g0[4], g1[4]; u32x2 a0[4], b0[4], a1[4], b1[4];
                    load_row(xo0, v0, lane); load_row(xo1, v1, lane);
                    load_vec(modl + (size_t)(t0 / TLAT) * 6144 + 5120, g0, lane); load_vec(modl + (size_t)(t1c / TLAT) * 6144 + 5120, g1, lane);
#pragma unroll
                    for (int j = 0; j < 4; ++j) { const int c = 4 * lane + 256 * j;
                        a0[j] = *(const u32x2*)(YS + (size_t)(2 * t0) * D + c); b0[j] = *(const u32x2*)(YS + (size_t)(2 * t0 + 1) * D + c);
                        a1[j] = *(const u32x2*)(YS + (size_t)(2 * t1c) * D + c); b1[j] = *(const u32x2*)(YS + (size_t)(2 * t1c + 1) * D + c); }
                    f32x4 y0[4], y1[4];
#pragma unroll
                    for (int j = 0; j < 4; ++j) {
                        y0[j] = (f32x4){bflo(a0[j].x) + bflo(b0[j].x), bfhi(a0[j].x) + bfhi(b0[j].x), bflo(a0[j].y) + bflo(b0[j].y), bfhi(a0[j].y) + bfhi(b0[j].y)};
                        y1[j] = (f32x4){bflo(a1[j].x) + bflo(b1[j].x), bfhi(a1[j].x) + bfhi(b1[j].x), bflo(a1[j].y) + bflo(b1[j].y), bfhi(a1[j].y) + bfhi(b1[j].y)}; }
                    const float r0 = row_rstd(y0), r1 = row_rstd(y1);
#pragma unroll
                    for (int j = 0; j < 4; ++j) { const int c = 4 * lane + 256 * j;
                        *(f32x4*)(xo0 + c) = v0[j] + g0[j] * (y0[j] * r0 * pgv[j]);
                        if (h1) *(f32x4*)(xo1 + c) = v1[j] + g1[j] * (y1[j] * r1 * pgv[j]); }
                }
            }
        }
    }
#undef IN
#undef SEAM
#undef CVT_MIXER
}

extern "C" void kernel_launch(void* const* d_in, const int* in_sizes, int n_in, void* d_out, int out_size, void* d_ws, size_t ws_size, hipStream_t stream) {
    static int grid = 0;
    if (grid == 0) {
        if (n_in != 34 || out_size != NB * TLAT * D || ws_size < WS_END) { fprintf(stderr, "kernel_launch: unexpected problem (n_in %d out %d ws %zu)\n", n_in, out_size, ws_size); grid = -1; return; }
        int dev = 0, cus = 0, per_cu = 0;
        if (hipGetDevice(&dev) != hipSuccess || hipDeviceGetAttribute(&cus, hipDeviceAttributeMultiprocessorCount, dev) != hipSuccess) { grid = -1; return; }
        if (hipFuncSetAttribute((const void*)mk_fwd, hipFuncAttributeMaxDynamicSharedMemorySize, LDS_BYTES) != hipSuccess) { fprintf(stderr, "kernel_launch: hipFuncSetAttribute failed\n"); grid = -1; return; }
        if (hipOccupancyMaxActiveBlocksPerMultiprocessor(&per_cu, (const void*)mk_fwd, NTHR, LDS_BYTES) != hipSuccess || per_cu < 1) fprintf(stderr, "kernel_launch: occupancy query says %d\n", per_cu);
        (void)hipGetLastError();
        grid = cus;
    }
    if (grid < 0) return;
    if (hipMemsetAsync((char*)d_ws + WS_CTL, 0, CTL_BYTES, stream) != hipSuccess) return;
    Args a{};
    for (int i = 0; i < 34; ++i) a.in[i] = (const float*)d_in[i];
    a.out = (float*)d_out; a.ws = (unsigned char*)d_ws;
#if MK_SINGLE
    a.ph_lo = 0; a.ph_hi = N_PHASES;
    hipLaunchKernelGGL(mk_fwd, dim3(grid), dim3(NTHR), LDS_BYTES, stream, a);
#else
    for (int p = 0; p < N_PHASES; ++p) { a.ph_lo = p; a.ph_hi = p + 1; hipLaunchKernelGGL(mk_fwd, dim3(grid), dim3(NTHR), LDS_BYTES, stream, a); }
#endif
}
```

```cpp
#include <hip/hip_runtime.h>
#include <cstdio>
#include <cstdint>

#ifndef PROBE_ML
#define PROBE_ML 1
#endif
#ifndef PROBE_DUP
#define PROBE_DUP 0
#endif
#define REP(j) for (int rep_ = 0; rep_ < ((((PROBE_DUP) >> (j)) & 1) ? 2 : 1); ++rep_)
#ifndef MK_SINGLE
#define MK_SINGLE 1
#endif

#define LAS __attribute__((address_space(3)))
typedef unsigned short bf16;
typedef short bf16x8 __attribute__((ext_vector_type(8)));
typedef float f32x4 __attribute__((ext_vector_type(4)));
typedef float f32x16 __attribute__((ext_vector_type(16)));
typedef unsigned u32x4 __attribute__((ext_vector_type(4)));
typedef unsigned u32x2 __attribute__((ext_vector_type(2)));
typedef float f32x2_t __attribute__((ext_vector_type(2)));
typedef __bf16 bf16x2_t __attribute__((ext_vector_type(2)));

constexpr int NB = 8, TLAT = 4096, NCTX = 256, SEQ = NCTX + TLAT  , R = NB * SEQ  ;
constexpr int D = 1024, NIN = 7440, NP = 4352  ;
constexpr int DFF = 2816, NEXP = 8, DFE = 1408;
constexpr int PA_Q = 0, PA_K = 512, PA_V = 640, PB_Q = 768, PB_K = 1280, PB_V = 1792, PC_Q = 2304, PC_K = 2816, PC_V = 3328, PC_O = 3840;
constexpr float EPS = 1e-6f;
constexpr float C2 = 0.125f * 1.4426950408889634f;
constexpr int NWAVES = 8, NTHR = 512;

constexpr size_t MiB = 1u << 20;
constexpr size_t WS_CTL = 0, CTL_BYTES = 1 * MiB;
constexpr size_t WS_MOD = 1 * MiB;
constexpr size_t WS_ROPE = WS_MOD + 512 * 1024;
constexpr size_t WS_GATES = 2 * MiB;
constexpr size_t WS_MOE = 5 * MiB;
constexpr size_t WS_CTXRES = 7 * MiB;
constexpr size_t WS_W = 15 * MiB;
constexpr size_t W_IN = WS_W, W_G = W_IN + (size_t)NP * D * 2, W_A = W_G + (size_t)3072 * D * 2, W_B = W_A + (size_t)1024 * 512 * 2, W_C = W_B + (size_t)1024 * 512 * 2,
                 W_O = W_C + (size_t)1024 * 512 * 2, W_END = W_O + (size_t)D * D * 2;
static_assert(W_END <= 35 * MiB && W_B - W_A == MiB && W_C - W_B == MiB, "W region");
constexpr size_t WS_R0 = 35 * MiB;
constexpr size_t WS_R2 = 103 * MiB;
constexpr size_t WS_R1 = 205 * MiB;
constexpr size_t WS_CQK = WS_R2;
constexpr size_t WS_END = 494 * MiB;
constexpr size_t SZ_RD = (size_t)R * D * 2;
static_assert(SZ_RD == 68 * MiB && (size_t)R * NP * 2 == 289 * MiB, "sizes");
constexpr size_t WS_AO = WS_R2, WS_BO = WS_R2 + 34 * MiB, WS_MO = WS_R2 + 68 * MiB;
constexpr size_t WS_G = WS_R1, WS_U = WS_R1 + 204 * MiB, WS_Y = WS_R1, WS_H = WS_R1;
constexpr size_t WS_Y2 = WS_R2;
constexpr size_t WS_WFF = 171 * MiB;
constexpr size_t WFF_GU = WS_WFF, WFF_D = WS_WFF + (size_t)2 * DFF * D * 2;
static_assert(WFF_D + (size_t)D * DFF * 2 <= WS_R1, "ffn weights inside R2");
constexpr int XG_ROWS = 2 * NB * TLAT + NEXP * 256;
constexpr size_t WS_XG = WS_R2;
constexpr size_t WS_YS = WS_R2;
constexpr size_t WS_HM = 235 * MiB;
constexpr size_t WS_WM = 417 * MiB;
constexpr size_t WM_GU = WS_WM, WM_D = WS_WM + (size_t)NEXP * 2 * DFE * D * 2;
static_assert(WS_XG + (size_t)XG_ROWS * D * 2 <= WS_HM && WS_HM + (size_t)XG_ROWS * DFE * 2 <= WS_WM && WM_D + (size_t)NEXP * D * DFE * 2 <= WS_END, "moe map");
constexpr size_t MOE_TOKE = WS_MOE, MOE_TOKP = MOE_TOKE + 2 * 32768 * 4, MOE_TOKW = MOE_TOKP + 2 * 32768 * 4, MOE_ROWSLOT = MOE_TOKW + 2 * 32768 * 4, MOE_ROWW = MOE_ROWSLOT + (size_t)XG_ROWS * 4;
static_assert(MOE_ROWW + (size_t)XG_ROWS * 4 <= WS_CTXRES, "moe lists");
constexpr int CW_BAR = 4096;
constexpr int CW_CNT = 16384;

constexpr int RING_BYTES = 131072;
constexpr int MISC_OFF = RING_BYTES + 320;
constexpr int LDS_BYTES = 147456;
constexpr int PTAB_OFF = RING_BYTES + 1024;

__device__ __forceinline__ unsigned cvtpk(float lo, float hi) { f32x2_t v = {lo, hi}; bf16x2_t b = __builtin_convertvector(v, bf16x2_t); return __builtin_bit_cast(unsigned, b); }
__device__ __forceinline__ bf16 f2bf(float f) { return (bf16)(cvtpk(f, 0.f) & 0xffffu); }
__device__ __forceinline__ float bflo(unsigned w) { return __uint_as_float(w << 16); }
__device__ __forceinline__ float bfhi(unsigned w) { return __uint_as_float(w & 0xffff0000u); }
__device__ __forceinline__ float bf2f(bf16 h) { return __uint_as_float(((unsigned)h) << 16); }
__device__ __forceinline__ float sigmoidf_(float x) { return __builtin_amdgcn_rcpf(1.f + __builtin_amdgcn_exp2f(-1.4426950408889634f * x)); }
__device__ __forceinline__ float invsigmoidf_(float x) { return 1.f + __builtin_amdgcn_exp2f(fminf(-1.4426950408889634f * x, 20.f)); }
__device__ __forceinline__ float siluf_(float x) { return x * __builtin_amdgcn_rcpf(1.f + __builtin_amdgcn_exp2f(-1.4426950408889634f * x)); }
__device__ __forceinline__ float logsigmoidf_(float x) { const float e = __expf(-fabsf(x)); const float l1p = (e < 1e-4f) ? e * (1.f - 0.5f * e) : __logf(1.f + e); return fminf(x, 0.f) - l1p; }
__device__ __forceinline__ float dpp_add(float v, const int ctrl_sel) {
    int r;
    if (ctrl_sel == 0) r = __builtin_amdgcn_update_dpp(0, __builtin_bit_cast(int, v), 0xB1, 0xF, 0xF, true);
    else if (ctrl_sel == 1) r = __builtin_amdgcn_update_dpp(0, __builtin_bit_cast(int, v), 0x4E, 0xF, 0xF, true);
    else if (ctrl_sel == 2) r = __builtin_amdgcn_update_dpp(0, __builtin_bit_cast(int, v), 0x141, 0xF, 0xF, true);
    else r = __builtin_amdgcn_update_dpp(0, __builtin_bit_cast(int, v), 0x140, 0xF, 0xF, true);
    return v + __builtin_bit_cast(float, r);
}
__device__ __forceinline__ float row16_sum(float v) { v = dpp_add(v, 0); v = dpp_add(v, 1); v = dpp_add(v, 2); v = dpp_add(v, 3); return v; }
__device__ __forceinline__ float wave_sum(float v) {
    v = row16_sum(v);
    const int iv = __builtin_bit_cast(int, v);
    const float a = __builtin_bit_cast(float, __builtin_amdgcn_readlane(iv, 0)), b = __builtin_bit_cast(float, __builtin_amdgcn_readlane(iv, 16));
    const float c = __builtin_bit_cast(float, __builtin_amdgcn_readlane(iv, 32)), d = __builtin_bit_cast(float, __builtin_amdgcn_readlane(iv, 48));
    return (a + b) + (c + d);
}

#define XB_TMO      128
#define XB_XCNT(j)  (256  + 64 * (j))
#define XB_XSUB(j)  (1280 + 64 * (j))
#define XB_XGEN(j)  (2304 + 64 * (j))
#define XB_TOP      3328
#define XB_TOPGEN   3392
#define XCD_BAR_WORDS 3456
#define XB_SPIN_CAP (1u << 18)
__device__ __forceinline__ unsigned xb_ld(unsigned* p)              { return __hip_atomic_load(p, __ATOMIC_RELAXED, __HIP_MEMORY_SCOPE_AGENT); }
__device__ __forceinline__ unsigned xb_add(unsigned* p, unsigned v) { return __hip_atomic_fetch_add(p, v, __ATOMIC_RELAXED, __HIP_MEMORY_SCOPE_AGENT); }
__device__ __forceinline__ unsigned xb_xcc_id() { return (unsigned)__builtin_amdgcn_s_getreg((3 << 11) | 20) & 0xFu; }
#define XB_SPIN(cond, bar) do { unsigned _sp = 0; while (cond) { __builtin_amdgcn_s_sleep(1); \
    if ((++_sp & 255u) == 0u) { if (xb_ld(&(bar)[XB_TMO])) break; if (_sp > XB_SPIN_CAP) { atomicAdd(&(bar)[XB_TMO], 1u); break; } } } } while (0)
struct XcdBarrier { unsigned* bar; unsigned x; volatile LAS unsigned* st; };
__device__ __forceinline__ XcdBarrier xcd_barrier_post(unsigned* bar, volatile LAS unsigned* st) {
    XcdBarrier b; b.bar = bar; b.x = xb_xcc_id(); b.st = st;
    if (threadIdx.x == 0) (void)xb_add(&bar[XB_XCNT(b.x)], 1u);
    return b;
}
__device__ __forceinline__ void xcd_barrier_complete(unsigned* bar, unsigned x, unsigned& nloc, unsigned& nx) {
    const unsigned G = gridDim.x * gridDim.y * gridDim.z;
    unsigned sum, cnt, mine, sp = 0u;
    for (;;) {
        sum = 0u; cnt = 0u; mine = 0u;
#pragma unroll
        for (unsigned j = 0; j < 16; ++j) { const unsigned c = xb_ld(&bar[XB_XCNT(j)]); sum += c; cnt += (c > 0u) ? 1u : 0u; mine = (j == x) ? c : mine; }
        if (sum == G) break;
        __builtin_amdgcn_s_sleep(1);
        if ((++sp & 255u) == 0u) { if (xb_ld(&bar[XB_TMO])) break; if (sp > XB_SPIN_CAP) { atomicAdd(&bar[XB_TMO], 1u); break; } }
    }
    nloc = mine > 0u ? mine : 1u; nx = cnt > 0u ? cnt : 1u;
}
__device__ __forceinline__ void xcd_barrier(const XcdBarrier& b) {
    asm volatile("s_waitcnt vmcnt(0)" ::: "memory");
    __syncthreads();
    if (threadIdx.x == 0) {
        unsigned* bar = b.bar;
        __builtin_amdgcn_s_waitcnt(0);
        unsigned nloc = b.st[0], nx = b.st[1];
        if (nloc == 0u) { xcd_barrier_complete(bar, b.x, nloc, nx); b.st[0] = nloc; b.st[1] = nx; }
        const unsigned old = xb_add(&bar[XB_XSUB(b.x)], 1u);
        const unsigned gen = old / nloc;
        if (old + 1u == (gen + 1u) * nloc) {
            __builtin_amdgcn_fence(__ATOMIC_RELEASE, "agent");
            asm volatile("s_waitcnt vmcnt(0)" ::: "memory");
            const unsigned og = xb_add(&bar[XB_TOP], 1u);
            const unsigned tg = og / nx;
            if (og + 1u == (tg + 1u) * nx) xb_add(&bar[XB_TOPGEN], 1u);
            else XB_SPIN(xb_ld(&bar[XB_TOPGEN]) == tg, bar);
            __builtin_amdgcn_fence(__ATOMIC_ACQUIRE, "agent");
            xb_add(&bar[XB_XGEN(b.x)], 1u);
            asm volatile("s_waitcnt vmcnt(0)" ::: "memory");
        } else {
            XB_SPIN(xb_ld(&bar[XB_XGEN(b.x)]) == gen, bar);
            __builtin_amdgcn_fence(__ATOMIC_ACQUIRE, "agent");
            asm volatile("s_waitcnt vmcnt(0)" ::: "memory");
        }
    }
    __syncthreads();
}

namespace pg8 {
constexpr int BM = 256, BK = 64, HALF = 128, HTB = HALF * BK * 2, STAGE_BYTES = 8 * HTB, NXCD = 8, WGM = 8;
__host__ __device__ __forceinline__ int lds_byte(int r, int c) { const int st = (r >> 4) * 2 + (c >> 5), rr = r & 15, cc = c & 31, ob = rr * 64 + cc * 2; return st * 1024 + (ob ^ (((ob >> 9) & 1) << 5)); }
__host__ __device__ __forceinline__ void stage_rc(int b, int& Rr, int& C) { const int st = b / 1024, sb = b % 1024, swz = sb ^ (((sb >> 9) & 1) << 5); Rr = (st >> 1) * 16 + swz / 64; C = (st & 1) * 32 + (swz % 64) / 2; }

struct Unit { int pm, pn, aux; const char* a; const char* b; };
struct GemmP { int K, lda, ldb; };

__device__ __forceinline__ void tile_of(int L, int nM, int nN, int& pm, int& pn) {
    const int nwg = nM * nN;
    int wgid = L; { const int q = nwg / NXCD, r = nwg % NXCD, xcd = wgid % NXCD, off = wgid / NXCD; wgid = (xcd < r ? xcd * (q + 1) : r * (q + 1) + (xcd - r) * q) + off; }
    const int nig = WGM * nN, gid = wgid / nig, fm = gid * WGM, gsz = (nM - fm) < WGM ? (nM - fm) : WGM;
    pm = fm + ((wgid % nig) % gsz); pn = (wgid % nig) / gsz;
}
struct StaticOrder {
    static constexpr bool CHAIN = false;
    int nM, nN, nwg, G, c, lat; const char* A; const char* B; size_t ta, tb;
    __device__ void init(int M, int N, int G_, int c_, const void* A_, int lda, const void* B_, int ldb, int lat_ = 0) { nM = M / BM; if (lat_) nM = nM / 17 * 16; nN = N / BM; nwg = nM * nN; G = G_; c = c_; lat = lat_; A = (const char*)A_; B = (const char*)B_; ta = (size_t)BM * lda * 2; tb = (size_t)BM * ldb * 2; }
    __device__ __forceinline__ bool next(int i, Unit& u) const {
        const long L = (long)i * G + c; if (L >= nwg) return false;
        tile_of((int)L, nM, nN, u.pm, u.pn); if (lat) u.pm += (u.pm >> 4) + 1; u.aux = 0; u.a = A + (size_t)u.pm * ta; u.b = B + (size_t)u.pn * tb; return true;
    }
};

template <class Epi, class Sched>
__device__ __forceinline__ void gemm_phase(LAS unsigned char* lds, const GemmP g, const Sched& S, const Epi& E) {
    int tid_ = threadIdx.x; asm volatile("" : "+v"(tid_));
    const int tid = tid_, wid = __builtin_amdgcn_readfirstlane(tid >> 6), lane = tid & 63, wr = wid >> 2, wc = wid & 3, fr = lane & 15, fq = lane >> 4;
    const int K = g.K, nt = K / BK;
    unsigned voffA[2], voffB[2];
#pragma unroll
    for (int i = 0; i < 2; ++i) { int Rr, C; stage_rc(tid * 16 + i * 8192, Rr, C); voffA[i] = (unsigned)(Rr * g.lda + C) * 2u; voffB[i] = (unsigned)(Rr * g.ldb + C) * 2u; }
    const size_t kstep = (size_t)(BK * 2);
    const size_t hstepA = (size_t)HALF * g.lda * 2, hstepB = (size_t)HALF * g.ldb * 2;
    const unsigned ldsw = (unsigned)wid * 1024u;
    const int aoff = lds_byte(wr * 64 + fr, fq * 8), boff = lds_byte(wc * 32 + fr, fq * 8);
#define PG8_SA(b, h) (((b) * 2 + (h)) * HTB)
#define PG8_SB(b, h) ((4 + (b) * 2 + (h)) * HTB)
#define PG8_STAGE(bufoff, gbase, voff) do { _Pragma("unroll") for (int _i = 0; _i < 2; ++_i) \
        __builtin_amdgcn_global_load_lds((const unsigned*)((const char*)(gbase) + (voff)[_i]), (LAS unsigned*)(lds + (bufoff) + ldsw + _i * 8192), 16, 0, 0); } while (0)
#define PG8_LDA(dst, b, h) do { _Pragma("unroll") for (int m = 0; m < 4; ++m) _Pragma("unroll") for (int k = 0; k < 2; ++k) dst[m][k] = *(const LAS bf16x8*)(lds + PG8_SA(b, h) + aoff + m * 2048 + k * 1024); } while (0)
#define PG8_LDB(dst, b, h) do { _Pragma("unroll") for (int n = 0; n < 2; ++n) _Pragma("unroll") for (int k = 0; k < 2; ++k) dst[n][k] = *(const LAS bf16x8*)(lds + PG8_SB(b, h) + boff + n * 2048 + k * 1024); } while (0)
#define PG8_MMA(ai, bj, At, Bt) do { __builtin_amdgcn_s_setprio(1); _Pragma("unroll") for (int m = 0; m < 4; ++m) _Pragma("unroll") for (int n = 0; n < 2; ++n) _Pragma("unroll") for (int k = 0; k < 2; ++k) \
        acc[ai][bj][m][n] = __builtin_amdgcn_mfma_f32_16x16x32_bf16(Bt[n][k], At[m][k], acc[ai][bj][m][n], 0, 0, 0); __builtin_amdgcn_s_setprio(0); } while (0)
#define PG8_WAIT_V(n) asm volatile("s_waitcnt vmcnt(" #n ")" ::: "memory")
#define PG8_WAIT_L(n) asm volatile("s_waitcnt lgkmcnt(" #n ")" ::: "memory")
#define PG8_BAR __builtin_amdgcn_s_barrier()
#define PG8_SCHED __builtin_amdgcn_sched_barrier(0)
    Unit cur, nxt; int ui = 0;
    if (!S.next(0, cur)) return;
    f32x4 acc[2][2][4][2];
#pragma unroll
    for (int a = 0; a < 2; ++a)
#pragma unroll
        for (int b = 0; b < 2; ++b)
#pragma unroll
            for (int m = 0; m < 4; ++m)
#pragma unroll
                for (int n = 0; n < 2; ++n) acc[a][b][m][n] = (f32x4){0.f, 0.f, 0.f, 0.f};
    bf16x8 At[4][2], B0[2][2], B1[2][2];
    const char* cA = cur.a; const char* cB = cur.b;
    PG8_STAGE(PG8_SB(0, 0), cB, voffB); PG8_STAGE(PG8_SB(0, 1), cB + hstepB, voffB); PG8_STAGE(PG8_SA(0, 0), cA, voffA); PG8_STAGE(PG8_SA(0, 1), cA + hstepA, voffA);
    if (wr == 1) PG8_BAR;
    PG8_WAIT_V(2); PG8_BAR;
    PG8_STAGE(PG8_SB(1, 0), cB + kstep, voffB); PG8_STAGE(PG8_SA(1, 0), cA + kstep, voffA); PG8_STAGE(PG8_SB(1, 1), cB + hstepB + kstep, voffB);
    PG8_WAIT_V(6); PG8_BAR;
    for (;;) {
        const bool has_next = S.next(ui + 1, nxt);
        const char* nA = has_next ? nxt.a : cA; const char* nB = has_next ? nxt.b : cB;
        for (int t = 0; t < nt; t += 2) {
            const bool last = (t == nt - 2);
            const char* a1 = cA + (size_t)(t + 1) * kstep;
            const char* a2 = last ? nA : cA + (size_t)(t + 2) * kstep; const char* b2 = last ? nB : cB + (size_t)(t + 2) * kstep;
            const char* a3 = a2 + kstep; const char* b3 = b2 + kstep;
            PG8_LDB(B0, 0, 0); PG8_LDB(B1, 0, 1); PG8_SCHED; PG8_LDA(At, 0, 0); PG8_STAGE(PG8_SA(1, 1), a1 + hstepA, voffA);
            PG8_WAIT_V(8); PG8_WAIT_L(0); PG8_BAR; PG8_MMA(0, 0, At, B0); PG8_MMA(0, 1, At, B1); PG8_BAR; PG8_SCHED;
            PG8_LDA(At, 0, 1); PG8_STAGE(PG8_SB(0, 0), b2, voffB); PG8_STAGE(PG8_SB(0, 1), b2 + hstepB, voffB); PG8_STAGE(PG8_SA(0, 0), a2, voffA);
            PG8_WAIT_V(8); PG8_WAIT_L(0); PG8_BAR; PG8_MMA(1, 0, At, B0); PG8_MMA(1, 1, At, B1); PG8_BAR; PG8_SCHED;
            PG8_LDB(B0, 1, 0); PG8_LDB(B1, 1, 1); PG8_SCHED; PG8_LDA(At, 1, 0); PG8_STAGE(PG8_SA(0, 1), a2 + hstepA, voffA);
            PG8_WAIT_V(8); PG8_WAIT_L(0); PG8_BAR; PG8_MMA(0, 0, At, B0); PG8_MMA(0, 1, At, B1); PG8_BAR; PG8_SCHED;
            PG8_LDA(At, 1, 1); PG8_STAGE(PG8_SB(1, 0), b3, voffB); PG8_STAGE(PG8_SB(1, 1), b3 + hstepB, voffB); PG8_STAGE(PG8_SA(1, 0), a3, voffA);
            PG8_WAIT_V(8); PG8_WAIT_L(0); PG8_BAR; PG8_MMA(1, 0, At, B0); PG8_MMA(1, 1, At, B1); PG8_BAR; PG8_SCHED;
        }
        if (wr == 0) PG8_BAR;
        E(acc, cur, wr, wc, fr, fq);
        if (!has_next) break;
        if (!(Sched::CHAIN && nxt.aux != 0)) {
#pragma unroll
        for (int a = 0; a < 2; ++a)
#pragma unroll
            for (int b = 0; b < 2; ++b)
#pragma unroll
                for (int m = 0; m < 4; ++m)
#pragma unroll
                    for (int n = 0; n < 2; ++n) acc[a][b][m][n] = (f32x4){0.f, 0.f, 0.f, 0.f};
        }
        cur = nxt; cA = nA; cB = nB; ++ui;
        if (wr == 1) PG8_BAR;
    }
    PG8_WAIT_V(0);
    PG8_BAR;
#undef PG8_SA
#undef PG8_SB
#undef PG8_STAGE
#undef PG8_LDA
#undef PG8_LDB
#undef PG8_MMA
#undef PG8_WAIT_V
#undef PG8_WAIT_L
#undef PG8_BAR
#undef PG8_SCHED
}
}
using pg8::Unit;

#define EPI_ARGS f32x4 (&acc)[2][2][4][2], const Unit& u, int wr, int wc, int fr, int fq
struct EpiInProj {
    bf16* P; LAS const float* qg; LAS const float* kg; LAS const float* ropec; LAS const float* ropes;
    __device__ __forceinline__ void operator()(EPI_ARGS) const {
        const int slot = 4 * u.pn + wc;
        const bool is_q = slot < 8 || (slot >= 12 && slot < 20);
        const bool do_norm = slot < 10;
        const bool do_rope = (slot < 10 || (slot >= 12 && slot < 28)) && (u.pm % 17 != 0);
        LAS const float* g = slot < 8 ? qg : kg;
        const float qs = is_q ? C2 : 1.f;
#pragma unroll
        for (int ai = 0; ai < 2; ++ai)
#pragma unroll
            for (int m = 0; m < 4; ++m) {
                const int r = u.pm * 256 + ai * 128 + wr * 64 + m * 16 + fr;
                f32x4 v[2][2];
#pragma unroll
                for (int bj = 0; bj < 2; ++bj)
#pragma unroll
                    for (int n = 0; n < 2; ++n) v[bj][n] = acc[ai][bj][m][n];
                if (do_norm) {
                    float ss = 0.f;
#pragma unroll
                    for (int bj = 0; bj < 2; ++bj)
#pragma unroll
                        for (int n = 0; n < 2; ++n) ss += (v[bj][n][0] * v[bj][n][0] + v[bj][n][1] * v[bj][n][1]) + (v[bj][n][2] * v[bj][n][2] + v[bj][n][3] * v[bj][n][3]);
                    { auto r16_ = __builtin_amdgcn_permlane16_swap(__float_as_uint(ss), __float_as_uint(ss), false, false); ss = __uint_as_float(r16_[0]) + __uint_as_float(r16_[1]); }
                    { auto r32_ = __builtin_amdgcn_permlane32_swap(__float_as_uint(ss), __float_as_uint(ss), false, false); ss = __uint_as_float(r32_[0]) + __uint_as_float(r32_[1]); }
                    const float rstd = __builtin_amdgcn_rsqf(ss * (1.f / 64.f) + EPS);
#pragma unroll
                    for (int bj = 0; bj < 2; ++bj)
#pragma unroll
                        for (int n = 0; n < 2; ++n) v[bj][n] = v[bj][n] * rstd * *(LAS const f32x4*)(g + 32 * bj + 16 * n + 4 * fq);
                }
                if (do_rope) {
                    const int t = (r % SEQ) - NCTX;
#pragma unroll
                    for (int bj = 0; bj < 2; ++bj) {
                        const int p = bj == 0 ? (t >> 6) : (t & 63);
                        const f32x4 cs = *(LAS const f32x4*)(ropec + p * 16 + 4 * fq), sn = *(LAS const f32x4*)(ropes + p * 16 + 4 * fq);
                        const f32x4 x1 = v[bj][0], x2 = v[bj][1];
                        v[bj][0] = x1 * cs - x2 * sn; v[bj][1] = x2 * cs + x1 * sn;
                    }
                }
                bf16* rowp = P + (size_t)r * NP + 64 * slot + 16 * (fq & 1) + 8 * (fq >> 1);
#pragma unroll
                for (int bj = 0; bj < 2; ++bj) { const f32x4 o0 = v[bj][0] * qs, o1 = v[bj][1] * qs;
                    const auto rx = __builtin_amdgcn_permlane16_swap(cvtpk(o0[0], o0[1]), cvtpk(o1[0], o1[1]), false, false);
                    const auto ry = __builtin_amdgcn_permlane16_swap(cvtpk(o0[2], o0[3]), cvtpk(o1[2], o1[3]), false, false);
                    *(u32x4*)(rowp + 32 * bj) = (u32x4){rx[0], ry[0], rx[1], ry[1]}; }
                asm volatile("" ::: "memory");
            }
    }
};
struct EpiSigmoid {
    bf16* O; int ldc;
    __device__ __forceinline__ void operator()(EPI_ARGS) const {
        bf16* tp = O + ((size_t)(u.pm * 12 + u.pn) << 16) + (size_t)((wr * 4 + wc) * 8192 + (fq * 16 + fr) * 8);
#pragma unroll
        for (int ai = 0; ai < 2; ++ai)
#pragma unroll
            for (int m = 0; m < 4; ++m)
#pragma unroll
                for (int bj = 0; bj < 2; ++bj) { const f32x4 v0 = acc[ai][bj][m][0], v1 = acc[ai][bj][m][1];
                    *(u32x4*)(tp + ((ai * 4 + m) * 2 + bj) * 512) = (u32x4){cvtpk(invsigmoidf_(v0[0]), invsigmoidf_(v0[1])), cvtpk(invsigmoidf_(v0[2]), invsigmoidf_(v0[3])), cvtpk(invsigmoidf_(v1[0]), invsigmoidf_(v1[1])), cvtpk(invsigmoidf_(v1[2]), invsigmoidf_(v1[3]))}; }
    }
};
struct EpiMerge {
    const bf16* G; bf16* U;
    __device__ __forceinline__ void operator()(EPI_ARGS) const {
        const int row0 = u.pm * 256 + wr * 64 + fr, col0 = u.pn * 256 + wc * 64 + fq * 16; const int br = u.aux;
        const bf16* gb = G + ((size_t)(u.pm * 12 + br * 4 + u.pn) << 16) + (size_t)((wr * 4 + wc) * 8192 + (fq * 16 + fr) * 8);
#pragma unroll
        for (int ai = 0; ai < 2; ++ai) {
            u32x4 gw[4][2], hw[4][2];
#pragma unroll
            for (int m = 0; m < 4; ++m)
#pragma unroll
                for (int bj = 0; bj < 2; ++bj) { const bf16* gp = gb + ((ai * 4 + m) * 2 + bj) * 512; gw[m][bj] = *(const u32x4*)gp; if (br != 2) hw[m][bj] = *(const u32x4*)(gp + 4 * 65536); }
#pragma unroll
            for (int m = 0; m < 4; ++m)
#pragma unroll
                for (int bj = 0; bj < 2; ++bj) {
                    const u32x4 g4 = gw[m][bj];
                    float s[8] = {bflo(g4.x), bfhi(g4.x), bflo(g4.y), bfhi(g4.y), bflo(g4.z), bfhi(g4.z), bflo(g4.w), bfhi(g4.w)};
#pragma unroll
                    for (int i = 0; i < 8; ++i) s[i] = __builtin_amdgcn_rcpf(s[i]);
                    if (br != 2) {
                        const u32x4 h4 = hw[m][bj];
                        const float d[8] = {bflo(h4.x), bfhi(h4.x), bflo(h4.y), bfhi(h4.y), bflo(h4.z), bfhi(h4.z), bflo(h4.w), bfhi(h4.w)};
#pragma unroll
                        for (int i = 0; i < 8; ++i) s[i] *= d[i];
                    }
                    f32x4& v0 = acc[ai][bj][m][0]; f32x4& v1 = acc[ai][bj][m][1];
                    v0[0] *= s[0]; v0[1] *= s[1]; v0[2] *= s[2]; v0[3] *= s[3]; v1[0] *= s[4]; v1[1] *= s[5]; v1[2] *= s[6]; v1[3] *= s[7];
                    if (br == 2) *(u32x4*)(U + (size_t)(row0 + ai * 128 + m * 16) * 1024 + col0 + bj * 8) = (u32x4){cvtpk(v0[0], v0[1]), cvtpk(v0[2], v0[3]), cvtpk(v1[0], v1[1]), cvtpk(v1[2], v1[3])}; }
        }
    }
};
struct EpiF32 {
    float* C; int ldc;
    __device__ __forceinline__ void operator()(EPI_ARGS) const {
        const int row0 = u.pm * 256 + wr * 64 + fr, col0 = u.pn * 256 + wc * 32 + 4 * fq;
#pragma unroll
        for (int ai = 0; ai < 2; ++ai)
#pragma unroll
            for (int m = 0; m < 4; ++m) { float* rowp = C + (size_t)(row0 + ai * 128 + m * 16) * ldc + col0;
#pragma unroll
                for (int bj = 0; bj < 2; ++bj)
#pragma unroll
                    for (int n = 0; n < 2; ++n) *(f32x4*)(rowp + bj * 128 + n * 16) = acc[ai][bj][m][n]; }
    }
};
struct EpiBf16 {
    bf16* O; int ldc;
    __device__ __forceinline__ void operator()(EPI_ARGS) const {
        const int row0 = u.pm * 256 + wr * 64 + fr, col0 = u.pn * 256 + wc * 32 + 16 * (fq & 1) + 8 * (fq >> 1);
#pragma unroll
        for (int ai = 0; ai < 2; ++ai)
#pragma unroll
            for (int m = 0; m < 4; ++m) { bf16* rowp = O + (size_t)(row0 + ai * 128 + m * 16) * ldc + col0;
#pragma unroll
                for (int bj = 0; bj < 2; ++bj) { const f32x4 v0 = acc[ai][bj][m][0], v1 = acc[ai][bj][m][1];
                    const auto rx = __builtin_amdgcn_permlane16_swap(cvtpk(v0[0], v0[1]), cvtpk(v1[0], v1[1]), false, false);
                    const auto ry = __builtin_amdgcn_permlane16_swap(cvtpk(v0[2], v0[3]), cvtpk(v1[2], v1[3]), false, false);
                    *(u32x4*)(rowp + bj * 128) = (u32x4){rx[0], ry[0], rx[1], ry[1]}; } }
    }
};
struct EpiSwiGLU {
    bf16* H; int ldc;
    __device__ __forceinline__ void operator()(EPI_ARGS) const {
        const int row0 = u.pm * 256 + wr * 64 + fr, col0 = u.pn * 128 + wc * 32 + 16 * (fq & 1) + 8 * (fq >> 1);
#pragma unroll
        for (int ai = 0; ai < 2; ++ai)
#pragma unroll
            for (int m = 0; m < 4; ++m) { bf16* rowp = H + (size_t)(row0 + ai * 128 + m * 16) * ldc + col0;
                const f32x4 g0 = acc[ai][0][m][0], u0 = acc[ai][1][m][0], g1 = acc[ai][0][m][1], u1 = acc[ai][1][m][1];
                const auto rx = __builtin_amdgcn_permlane16_swap(cvtpk(siluf_(g0[0]) * u0[0], siluf_(g0[1]) * u0[1]), cvtpk(siluf_(g1[0]) * u1[0], siluf_(g1[1]) * u1[1]), false, false);
                const auto ry = __builtin_amdgcn_permlane16_swap(cvtpk(siluf_(g0[2]) * u0[2], siluf_(g0[3]) * u0[3]), cvtpk(siluf_(g1[2]) * u1[2], siluf_(g1[3]) * u1[3]), false, false);
                *(u32x4*)rowp = (u32x4){rx[0], ry[0], rx[1], ry[1]}; }
    }
};
struct EpiMoeDown {
    bf16* YS; const int* rowslot; const float* roww;
    __device__ __forceinline__ void operator()(EPI_ARGS) const {
        const int row0 = u.pm * 256 + wr * 64 + fr, col0 = u.pn * 256 + wc * 32 + 16 * (fq & 1) + 8 * (fq >> 1);
#pragma unroll
        for (int ai = 0; ai < 2; ++ai)
#pragma unroll
            for (int m = 0; m < 4; ++m) { const int r = row0 + ai * 128 + m * 16; int slot = rowslot[r]; if ((unsigned)slot >= 2u * NB * TLAT) slot = -1; const float w = roww[r];
                bf16* rowp = YS + (size_t)(slot < 0 ? 0 : slot) * 1024 + col0;
#pragma unroll
                for (int bj = 0; bj < 2; ++bj) { const f32x4 v0 = acc[ai][bj][m][0] * w, v1 = acc[ai][bj][m][1] * w;
                    const auto rx = __builtin_amdgcn_permlane16_swap(cvtpk(v0[0], v0[1]), cvtpk(v1[0], v1[1]), false, false);
                    const auto ry = __builtin_amdgcn_permlane16_swap(cvtpk(v0[2], v0[3]), cvtpk(v1[2], v1[3]), false, false);
                    if (slot >= 0) *(u32x4*)(rowp + bj * 128) = (u32x4){rx[0], ry[0], rx[1], ry[1]}; }
                asm volatile("" ::: "memory"); }
    }
};

struct InProjOrder {
    static constexpr bool CHAIN = false;
    int G, c, skip; const char* A; const char* B;
    __device__ __forceinline__ bool next(int i, Unit& u) const {
        const int L = i * G + c;
        if (L < 128 * 17) { pg8::tile_of(L, 128, 17, u.pm, u.pn); u.pm += (u.pm >> 4) + 1; }
        else { const int j = L - 128 * 17; int b, k;
            if (skip) { if (j >= 72) return false; b = j / 9; k = j - 9 * b; k += 2 + (k > 0 ? 2 : 0) + (k > 4 ? 2 : 0); } else { if (j >= 136) return false; b = j / 17; k = j - 17 * b; }
            u.pm = 17 * b; u.pn = k; }
        u.aux = 0; u.a = A + (size_t)u.pm * (256 * D * 2); u.b = B + (size_t)u.pn * (256 * D * 2); return true;
    }
};
struct MergeOrder {
    static constexpr bool CHAIN = true;
    int nM, nN, nwg, G, c, lat; const char *A0, *B0;
    __device__ __forceinline__ bool next(int i, Unit& u) const {
        const int ti = i / 3, br = i - 3 * ti; const long L = (long)ti * G + c; if (L >= nwg) return false;
        pg8::tile_of((int)L, nM, nN, u.pm, u.pn); if (lat) u.pm += (u.pm >> 4) + 1; u.aux = br;
        const char* a = A0 + (size_t)br * (34 * MiB); const char* b = B0 + (size_t)br * (1 * MiB);
        u.a = a + (size_t)u.pm * (256 * 512 * 2); u.b = b + (size_t)u.pn * (256 * 512 * 2); return true;
    }
};
struct MoeOrder {
    static constexpr bool CHAIN = false;
    int tb[NEXP + 1]; int nN, G, c; const char* A; const char* B; size_t ta, tb_tile, tb_exp;
    __device__ __forceinline__ bool next(int i, Unit& u) const {
        const long L = (long)i * G + c; const int nwg = tb[NEXP] * nN; if (L >= nwg) return false;
        int w = (int)L; { const int q = nwg >> 3, r = nwg & 7, xcd = w & 7, off = w >> 3; w = (xcd < r ? xcd * (q + 1) : r * (q + 1) + (xcd - r) * q) + off; }
        const int rt = w / nN, pn = w % nN; int e = 0;
#pragma unroll
        for (int j = 1; j < NEXP; ++j) e += (rt >= tb[j]) ? 1 : 0;
        u.pm = rt; u.pn = pn; u.aux = e; u.a = A + (size_t)rt * ta; u.b = B + (size_t)e * tb_exp + (size_t)pn * tb_tile; return true;
    }
};

constexpr int AT_KP = 72;
constexpr int AT_KBYTES = 64 * AT_KP * 2;
typedef short v4i16_t __attribute__((ext_vector_type(4)));
template <int DV>
__device__ __forceinline__ void attn_pass(const bf16* qrow, const bf16* kbase, const bf16* vbase, int NT, LAS unsigned char* lds, f32x16 (&o)[DV / 32]) {
    constexpr int DB = DV / 32, VRB = DV * 2  , AT_BUF = 8192 + 64 * VRB, NVP = DV / 64  ;
    int tid_ = threadIdx.x; asm volatile("" : "+v"(tid_));
    const int tid = tid_, lane = tid & 63, wid = __builtin_amdgcn_readfirstlane(tid >> 6), r32 = lane & 31, hi = lane >> 5;
    bf16x8 qf[4];
#pragma unroll
    for (int ds = 0; ds < 4; ++ds) qf[ds] = *(const bf16x8*)(qrow + 16 * ds + 8 * hi);
    LAS unsigned char* qlds = lds + 4 * AT_BUF + wid * 4096;
    if (DV == 128) {
#pragma unroll
        for (int ds = 0; ds < 4; ++ds) *(LAS bf16x8*)(qlds + r32 * 128 + (((2 * ds + hi) ^ ((r32 >> 1) & 7)) * 16)) = qf[ds];
    }
#define AT_QF(ds) (DV == 64 ? qf[ds] : *(const LAS bf16x8*)(qlo_ + kr_off[ds]))
#pragma unroll
    for (int db = 0; db < DB; ++db)
#pragma unroll
        for (int r = 0; r < 16; ++r) o[db][r] = 0.f;
    f32x16 negm; const f32x16 zero16 = {0.f, 0.f, 0.f, 0.f, 0.f, 0.f, 0.f, 0.f, 0.f, 0.f, 0.f, 0.f, 0.f, 0.f, 0.f, 0.f};
#pragma unroll
    for (int r = 0; r < 16; ++r) negm[r] = 0.f;
    if (DV == 64) asm volatile("" : "+v"(negm));
    float mhat = 0.f, lsum = 0.f;
    const int drow = 8 * wid + (lane >> 3), dslot = lane & 7;
    const bf16* kptr = kbase + (size_t)drow * NP + 8 * (dslot ^ ((drow >> 1) & 7));
    const int vrow = (DV == 64) ? drow : 4 * wid + (lane >> 4);
    const int vchk = (DV == 64) ? (dslot ^ (4 * ((drow >> 1) & 1))) : ((lane & 15) ^ (4 * (vrow & 3)));
    const bf16* vptr = vbase + (size_t)vrow * NP + 8 * vchk;
    const unsigned dk_off = (unsigned)wid * 1024u, dv_off = 8192u + (unsigned)wid * 1024u, lds0 = (unsigned)(uintptr_t)lds;
    int kr_off[4];
#pragma unroll
    for (int ds = 0; ds < 4; ++ds) kr_off[ds] = r32 * 128 + (((2 * ds + hi) ^ ((r32 >> 1) & 7)) * 16);
    const int q4 = (lane & 15) >> 2, p4 = lane & 3, g1 = (lane >> 4) & 1;
    int vt_off[DB];
#pragma unroll
    for (int db = 0; db < DB; ++db) vt_off[db] = 8192 + (4 * hi + q4) * VRB + ((DV == 64 ? (db ^ (q4 >> 1)) : (db ^ q4)) * 64) + (2 * g1 + (p4 >> 1)) * 16 + 8 * (p4 & 1);
#define AT_GLDS(gsrc, ldsaddr) do { unsigned keep_; asm volatile("s_mov_b32 %0, m0\n\ts_mov_b32 m0, %2\n\ts_nop 0\n\tglobal_load_lds_dwordx4 %1, off\n\ts_mov_b32 m0, %0" : "=&s"(keep_) : "v"(gsrc), "s"(ldsaddr) : "memory"); } while (0)
#define AT_DMA(J) do { \
        AT_GLDS(kptr, (unsigned)__builtin_amdgcn_readfirstlane(lds0 + (J) * AT_BUF + dk_off)); \
        AT_GLDS(vptr, (unsigned)__builtin_amdgcn_readfirstlane(lds0 + (J) * AT_BUF + dv_off)); \
        if (NVP == 2) AT_GLDS(vptr + (size_t)32 * NP, (unsigned)__builtin_amdgcn_readfirstlane(lds0 + (J) * AT_BUF + dv_off + 8192u)); \
        kptr += (size_t)64 * NP; vptr += (size_t)64 * NP; } while (0)
#define AT_VTR(p) __builtin_amdgcn_ds_read_tr16_b64_v4i16((LAS v4i16_t*)(p))
#define AT_QK(PN, KB, BLK) do { LAS unsigned char* qlo_ = qlds; asm volatile("" : "+v"(qlo_)); _Pragma("unroll") for (int ds = 0; ds < 4; ++ds) { \
            const bf16x8 kf = *(const LAS bf16x8*)((KB) + kr_off[ds] + 4096 * (BLK)); \
            PN = __builtin_amdgcn_mfma_f32_32x32x16_bf16(kf, AT_QF(ds), ds == 0 ? (DV == 64 ? negm : zero16) : PN, 0, 0, 0); } } while (0)
#define AT_VRD(VL, VH, KS, VBP, BLKP) do { _Pragma("unroll") for (int db = 0; db < DB; ++db) { \
            VL[db] = AT_VTR((VBP) + vt_off[db] + (32 * (BLKP) + 16 * (KS)) * VRB); VH[db] = AT_VTR((VBP) + vt_off[db] + (32 * (BLKP) + 16 * (KS) + 8) * VRB); } } while (0)
#define AT_VF(VL, VH, db) ((bf16x8){VL[db][0], VL[db][1], VL[db][2], VL[db][3], VH[db][0], VH[db][1], VH[db][2], VH[db][3]})
#define AT_PVM(VL, VH, PF, db) o[db] = __builtin_amdgcn_mfma_f32_32x32x16_bf16(AT_VF(VL, VH, db), PF, o[db], 0, 0, 0)
#define AT_QKM(PN, ds) PN = __builtin_amdgcn_mfma_f32_32x32x16_bf16(kf_[ds], AT_QF(ds), (ds) == 0 ? (DV == 64 ? negm : zero16) : PN, 0, 0, 0)
#define AT_EXPS(PC) do { float rs_ = 0.f; \
        _Pragma("unroll") for (int r = 0; r < 16; ++r) { const float e_ = __builtin_amdgcn_exp2f(DV == 64 ? PC[r] : PC[r] - mhat); PC[r] = e_; rs_ += e_; } \
        lsum += rs_; \
        np0_.x = cvtpk(PC[0], PC[1]); np0_.y = cvtpk(PC[2], PC[3]); np0_.z = cvtpk(PC[4], PC[5]); np0_.w = cvtpk(PC[6], PC[7]); \
        np1_.x = cvtpk(PC[8], PC[9]); np1_.y = cvtpk(PC[10], PC[11]); np1_.z = cvtpk(PC[12], PC[13]); np1_.w = cvtpk(PC[14], PC[15]); } while (0)
#define AT_SCALE_PK(W, F) do { W.x = cvtpk(bflo(W.x) * (F), bfhi(W.x) * (F)); W.y = cvtpk(bflo(W.y) * (F), bfhi(W.y) * (F)); W.z = cvtpk(bflo(W.z) * (F), bfhi(W.z) * (F)); W.w = cvtpk(bflo(W.w) * (F), bfhi(W.w) * (F)); } while (0)
#define AT_STEP_OLD(PC, PN, DO_QK, KB, NBLK, HAVE_PREV, VBP, BLKP, FIRST) do { \
        bf16x8 kf_[4]; LAS unsigned char* qlo_ = qlds; asm volatile("" : "+v"(qlo_)); \
        if (DV == 64 && (DO_QK)) { _Pragma("unroll") for (int ds = 0; ds < 4; ++ds) kf_[ds] = *(const LAS bf16x8*)((KB) + kr_off[ds] + 4096 * (NBLK)); } \
        if (HAVE_PREV) { _Pragma("unroll") for (int ks = 0; ks < 2; ++ks) { v4i16_t vl_[DB], vh_[DB]; \
            _Pragma("unroll") for (int db = 0; db < DB; ++db) { \
                vl_[db] = AT_VTR((VBP) + vt_off[db] + (32 * (BLKP) + 16 * ks) * VRB); vh_[db] = AT_VTR((VBP) + vt_off[db] + (32 * (BLKP) + 16 * ks + 8) * VRB); } \
            const bf16x8 pf_ = __builtin_bit_cast(bf16x8, ks == 0 ? pwp0 : pwp1); \
            _Pragma("unroll") for (int db = 0; db < DB; ++db) { \
                const bf16x8 vf_ = (bf16x8){vl_[db][0], vl_[db][1], vl_[db][2], vl_[db][3], vh_[db][0], vh_[db][1], vh_[db][2], vh_[db][3]}; \
                o[db] = __builtin_amdgcn_mfma_f32_32x32x16_bf16(vf_, pf_, o[db], 0, 0, 0); } \
            if (DV == 128) __builtin_amdgcn_sched_barrier(0); } } \
        if (DV == 128 && (DO_QK)) { _Pragma("unroll") for (int ds = 0; ds < 4; ++ds) kf_[ds] = *(const LAS bf16x8*)((KB) + kr_off[ds] + 4096 * (NBLK)); } \
        __builtin_amdgcn_sched_barrier(0); \
        float a_ = __builtin_fmaxf(__builtin_fmaxf(PC[0], PC[1]), PC[2]), b_ = __builtin_fmaxf(__builtin_fmaxf(PC[3], PC[4]), PC[5]); \
        a_ = __builtin_fmaxf(__builtin_fmaxf(a_, PC[6]), PC[7]); b_ = __builtin_fmaxf(__builtin_fmaxf(b_, PC[8]), PC[9]); \
        a_ = __builtin_fmaxf(__builtin_fmaxf(a_, PC[10]), PC[11]); b_ = __builtin_fmaxf(__builtin_fmaxf(b_, PC[12]), PC[13]); \
        a_ = __builtin_fmaxf(__builtin_fmaxf(a_, PC[14]), PC[15]); \
        float rm_ = __builtin_fmaxf(a_, b_); \
        { auto rr_ = __builtin_amdgcn_permlane32_swap(__float_as_uint(rm_), __float_as_uint(rm_), false, false); rm_ = __builtin_fmaxf(__uint_as_float(rr_[0]), __uint_as_float(rr_[1])); } \
        if (DV == 128) rm_ -= mhat; \
        if ((FIRST) || __any(rm_ > 8.f)) { const float dl_ = (FIRST) ? rm_ : __builtin_fmaxf(rm_, 0.f); mhat += dl_; \
            if (DV == 64) { _Pragma("unroll") for (int r = 0; r < 16; ++r) PC[r] -= dl_; \
                _Pragma("unroll") for (int r = 0; r < 16; ++r) negm[r] = -mhat; asm volatile("" : "+v"(negm)); } \
            const float f_ = __builtin_amdgcn_exp2f(-dl_); lsum *= f_; \
            _Pragma("unroll") for (int db = 0; db < DB; ++db) _Pragma("unroll") for (int r = 0; r < 16; ++r) o[db][r] *= f_; } \
        __builtin_amdgcn_sched_barrier(0); \
        if (DO_QK) { _Pragma("unroll") for (int ds = 0; ds < 4; ++ds) PN = __builtin_amdgcn_mfma_f32_32x32x16_bf16(kf_[ds], AT_QF(ds), ds == 0 ? (DV == 64 ? negm : zero16) : PN, 0, 0, 0); } \
        { float rs_ = 0.f; \
          _Pragma("unroll") for (int r = 0; r < 16; ++r) { const float e_ = __builtin_amdgcn_exp2f(DV == 64 ? PC[r] : PC[r] - mhat); PC[r] = e_; rs_ += e_; } \
          lsum += rs_; } \
        pwp0.x = cvtpk(PC[0], PC[1]); pwp0.y = cvtpk(PC[2], PC[3]); pwp0.z = cvtpk(PC[4], PC[5]); pwp0.w = cvtpk(PC[6], PC[7]); \
        pwp1.x = cvtpk(PC[8], PC[9]); pwp1.y = cvtpk(PC[10], PC[11]); pwp1.z = cvtpk(PC[12], PC[13]); pwp1.w = cvtpk(PC[14], PC[15]); \
        if (DO_QK) { __builtin_amdgcn_sched_group_barrier(0x002, 6, 0); \
            _Pragma("unroll") for (int i_ = 0; i_ < 4; ++i_) { __builtin_amdgcn_sched_group_barrier(0x008, 1, 0); __builtin_amdgcn_sched_group_barrier(0x002, 9, 0); } } \
        __builtin_amdgcn_sched_barrier(0); } while (0)
#define AT_STEP_NEW(PC, PN, DO_QK, KB, NBLK, HAVE_PREV, VBP, BLKP, FIRST) do { \
        bf16x8 kf_[4]; v4i16_t vl0_[DB], vh0_[DB], vl1_[DB], vh1_[DB]; u32x4 np0_, np1_; LAS unsigned char* qlo_ = qlds; asm volatile("" : "+v"(qlo_)); \
        if (DO_QK) { _Pragma("unroll") for (int ds = 0; ds < (DV == 64 ? 4 : 2); ++ds) kf_[ds] = *(const LAS bf16x8*)((KB) + kr_off[ds] + 4096 * (NBLK)); } \
        if (HAVE_PREV) { AT_VRD(vl0_, vh0_, 0, VBP, BLKP); if (DV == 64) AT_VRD(vl1_, vh1_, 1, VBP, BLKP); } \
        __builtin_amdgcn_sched_barrier(0); \
        float a_ = __builtin_fmaxf(__builtin_fmaxf(PC[0], PC[1]), PC[2]), b_ = __builtin_fmaxf(__builtin_fmaxf(PC[3], PC[4]), PC[5]); \
        a_ = __builtin_fmaxf(__builtin_fmaxf(a_, PC[6]), PC[7]); b_ = __builtin_fmaxf(__builtin_fmaxf(b_, PC[8]), PC[9]); \
        a_ = __builtin_fmaxf(__builtin_fmaxf(a_, PC[10]), PC[11]); b_ = __builtin_fmaxf(__builtin_fmaxf(b_, PC[12]), PC[13]); \
        a_ = __builtin_fmaxf(__builtin_fmaxf(a_, PC[14]), PC[15]); \
        float rm_ = __builtin_fmaxf(a_, b_); \
        { auto rr_ = __builtin_amdgcn_permlane32_swap(__float_as_uint(rm_), __float_as_uint(rm_), false, false); rm_ = __builtin_fmaxf(__uint_as_float(rr_[0]), __uint_as_float(rr_[1])); } \
        if (DV == 128) rm_ -= mhat; \
        if ((FIRST) || __any(rm_ > 8.f)) {     \
            const float dl_ = (FIRST) ? rm_ : __builtin_fmaxf(rm_, 0.f); mhat += dl_; \
            if (DV == 64) { _Pragma("unroll") for (int r = 0; r < 16; ++r) PC[r] -= dl_; \
                _Pragma("unroll") for (int r = 0; r < 16; ++r) negm[r] = -mhat; asm volatile("" : "+v"(negm)); } \
            const float f_ = __builtin_amdgcn_exp2f(-dl_); lsum *= f_; \
            _Pragma("unroll") for (int db = 0; db < DB; ++db) _Pragma("unroll") for (int r = 0; r < 16; ++r) o[db][r] *= f_; \
            if (HAVE_PREV) { AT_SCALE_PK(pwp0, f_); AT_SCALE_PK(pwp1, f_); } } \
        __builtin_amdgcn_sched_barrier(0); \
        const bf16x8 pf0_ = __builtin_bit_cast(bf16x8, pwp0), pf1_ = __builtin_bit_cast(bf16x8, pwp1); \
        if (DV == 64) { \
            if (DO_QK) AT_QKM(PN, 0); if (HAVE_PREV) AT_PVM(vl0_, vh0_, pf0_, 0); \
            if (DO_QK) AT_QKM(PN, 1); if (HAVE_PREV) AT_PVM(vl0_, vh0_, pf0_, 1); \
            if (DO_QK) AT_QKM(PN, 2); if (HAVE_PREV) AT_PVM(vl1_, vh1_, pf1_, 0); \
            if (DO_QK) AT_QKM(PN, 3); if (HAVE_PREV) AT_PVM(vl1_, vh1_, pf1_, 1); \
            AT_EXPS(PC); \
            if ((DO_QK) && (HAVE_PREV)) { _Pragma("unroll") for (int i_ = 0; i_ < 8; ++i_) { __builtin_amdgcn_sched_group_barrier(0x008, 1, 0); __builtin_amdgcn_sched_group_barrier(0x002, 5, 0); } } \
        } else { \
            if (DO_QK) AT_QKM(PN, 0); if (HAVE_PREV) { AT_PVM(vl0_, vh0_, pf0_, 0); AT_PVM(vl0_, vh0_, pf0_, 1); } \
            if (DO_QK) { AT_QKM(PN, 1); _Pragma("unroll") for (int ds = 2; ds < 4; ++ds) kf_[ds] = *(const LAS bf16x8*)((KB) + kr_off[ds] + 4096 * (NBLK)); } \
            if (HAVE_PREV) { AT_PVM(vl0_, vh0_, pf0_, 2); AT_PVM(vl0_, vh0_, pf0_, 3); AT_VRD(vl1_, vh1_, 1, VBP, BLKP); } \
            if (DO_QK) AT_QKM(PN, 2); if (HAVE_PREV) { AT_PVM(vl1_, vh1_, pf1_, 0); AT_PVM(vl1_, vh1_, pf1_, 1); } \
            if (DO_QK) AT_QKM(PN, 3); if (HAVE_PREV) { AT_PVM(vl1_, vh1_, pf1_, 2); AT_PVM(vl1_, vh1_, pf1_, 3); } \
            AT_EXPS(PC); \
        } \
        pwp0 = np0_; pwp1 = np1_; \
        __builtin_amdgcn_sched_barrier(0); } while (0)
#define AT_STEP(PC, PN, DO_QK, KB, NBLK, HAVE_PREV, VBP, BLKP, FIRST) do { if constexpr (DV == 64) AT_STEP_NEW(PC, PN, DO_QK, KB, NBLK, HAVE_PREV, VBP, BLKP, FIRST); else AT_STEP_OLD(PC, PN, DO_QK, KB, NBLK, HAVE_PREV, VBP, BLKP, FIRST); } while (0)
    f32x16 pa, pb; u32x4 pwp0, pwp1;
    AT_DMA(0); AT_DMA(1); AT_DMA(2);
    if (NVP == 2) asm volatile("s_waitcnt vmcnt(6)" ::: "memory"); else asm volatile("s_waitcnt vmcnt(4)" ::: "memory");
    __builtin_amdgcn_s_barrier(); asm volatile("" ::: "memory");
    AT_QK(pa, lds, 0);
    if (wid >= 4) __builtin_amdgcn_s_setprio(1);
#define AT_TILE(J, FIRST) do { const int t = t0 + (J); \
        if (FIRST) AT_STEP(pa, pb, true, lds + (J) * AT_BUF, 1, false, lds, 0, true); \
        else AT_STEP(pa, pb, true, lds + (J) * AT_BUF, 1, true, lds + (((J) + 3) & 3) * AT_BUF, 1, false); \
        if (t + 2 < NT) { if (NVP == 2) asm volatile("s_waitcnt vmcnt(3)" ::: "memory"); else asm volatile("s_waitcnt vmcnt(2)" ::: "memory"); } else asm volatile("s_waitcnt vmcnt(0)" ::: "memory"); \
        asm volatile("s_waitcnt lgkmcnt(0)" ::: "memory"); \
        __builtin_amdgcn_s_barrier(); asm volatile("" ::: "memory"); \
        if (t + 3 < NT) AT_DMA(((J) + 3) & 3); \
        if (t + 1 < NT) AT_STEP(pb, pa, true, lds + (((J) + 1) & 3) * AT_BUF, 0, true, lds + (J) * AT_BUF, 0, false); \
        else AT_STEP(pb, pa, false, lds + (((J) + 1) & 3) * AT_BUF, 0, true, lds + (J) * AT_BUF, 0, false); } while (0)
    for (int t0 = 0; t0 < NT; t0 += 4) {
        if (t0 == 0) AT_TILE(0, true); else AT_TILE(0, false);
        AT_TILE(1, false); AT_TILE(2, false); AT_TILE(3, false);
    }
#undef AT_TILE
    __builtin_amdgcn_s_setprio(0);
    {
        _Pragma("unroll") for (int ks = 0; ks < 2; ++ks) { const bf16x8 pf_ = __builtin_bit_cast(bf16x8, ks == 0 ? pwp0 : pwp1);
            _Pragma("unroll") for (int db = 0; db < DB; ++db) {
                const v4i16_t lo_ = AT_VTR(lds + 3 * AT_BUF + vt_off[db] + (32 + 16 * ks) * VRB), hi_ = AT_VTR(lds + 3 * AT_BUF + vt_off[db] + (32 + 16 * ks + 8) * VRB);
                const bf16x8 vf_ = (bf16x8){lo_[0], lo_[1], lo_[2], lo_[3], hi_[0], hi_[1], hi_[2], hi_[3]};
                o[db] = __builtin_amdgcn_mfma_f32_32x32x16_bf16(vf_, pf_, o[db], 0, 0, 0); } }
    }
#undef AT_DMA
#undef AT_QF
#undef AT_VRD
#undef AT_VF
#undef AT_PVM
#undef AT_QKM
#undef AT_EXPS
#undef AT_SCALE_PK
#undef AT_GLDS
#undef AT_VTR
#undef AT_QK
#undef AT_STEP
#undef AT_STEP_OLD
#undef AT_STEP_NEW
    lsum += __shfl_xor(lsum, 32);
    const float inv = 1.f / lsum;
#pragma unroll
    for (int db = 0; db < DB; ++db)
#pragma unroll
        for (int r = 0; r < 16; ++r) o[db][r] *= inv;
    __syncthreads();
}

__device__ __forceinline__ void attn_unit_a(const bf16* PROJ, bf16* AO, int q0, int k0, int NT, int h, LAS unsigned char* lds) {
    int tid_ = threadIdx.x; asm volatile("" : "+v"(tid_));
    const int tid = tid_, lane = tid & 63, wid = tid >> 6, r32 = lane & 31, hi = lane >> 5;
    const int qr = q0 + 32 * wid + r32, g = h >> 2;
    f32x16 o[2];
    attn_pass<64>(PROJ + (size_t)qr * NP + PA_Q + 64 * h, PROJ + (size_t)k0 * NP + PA_K + 64 * g, PROJ + (size_t)k0 * NP + PA_V + 64 * g, NT, lds, o);
    bf16* orow = AO + (size_t)qr * 512 + 64 * h + 4 * hi;
#pragma unroll
    for (int db = 0; db < 2; ++db)
#pragma unroll
        for (int rg = 0; rg < 4; ++rg) *(u32x2*)(orow + 32 * db + 8 * rg) = (u32x2){cvtpk(o[db][4 * rg], o[db][4 * rg + 1]), cvtpk(o[db][4 * rg + 2], o[db][4 * rg + 3])};
}
__device__ __forceinline__ u32x2 ld_own(const bf16* p) { const unsigned long long v = __hip_atomic_load((const unsigned long long*)p, __ATOMIC_RELAXED, __HIP_MEMORY_SCOPE_AGENT); return (u32x2){(unsigned)v, (unsigned)(v >> 32)}; }
__device__ __forceinline__ void attn_unit_b(const bf16* PROJ, bf16* BO, int q0, int k0, int NT, int hh, float lam, float oscale, const float* subg, LAS unsigned char* lds) {
    int tid_ = threadIdx.x; asm volatile("" : "+v"(tid_));
    const int tid = tid_, lane = tid & 63, wid = tid >> 6, r32 = lane & 31, hi = lane >> 5;
    const int qr = q0 + 32 * wid + r32;
    bf16* orow = BO + (size_t)qr * 512 + 128 * hh + 4 * hi;
    const bf16* qp = PROJ + (size_t)qr * NP + PB_Q + 128 * hh; const bf16* kp = PROJ + (size_t)k0 * NP + PB_K + 128 * hh; const bf16* vp = PROJ + (size_t)k0 * NP + PB_V + 128 * hh;
    f32x16 o[4];
    attn_pass<128>(qp, kp, vp, NT, lds, o);
#pragma unroll
    for (int db = 0; db < 4; ++db)
#pragma unroll
        for (int rg = 0; rg < 4; ++rg) *(u32x2*)(orow + 32 * db + 8 * rg) = (u32x2){cvtpk(o[db][4 * rg], o[db][4 * rg + 1]), cvtpk(o[db][4 * rg + 2], o[db][4 * rg + 3])};
    attn_pass<128>(qp + 64, kp + 64, vp, NT, lds, o);
    asm volatile("s_waitcnt vmcnt(0)" ::: "memory");
    float ss = 0.f;
#pragma unroll
    for (int db = 0; db < 4; ++db)
#pragma unroll
        for (int rg = 0; rg < 4; ++rg) { const u32x2 w1 = ld_own(orow + 32 * db + 8 * rg);
            const float d0 = bflo(w1.x) - lam * o[db][4 * rg], d1 = bfhi(w1.x) - lam * o[db][4 * rg + 1], d2 = bflo(w1.y) - lam * o[db][4 * rg + 2], d3 = bfhi(w1.y) - lam * o[db][4 * rg + 3];
            o[db][4 * rg] = d0; o[db][4 * rg + 1] = d1; o[db][4 * rg + 2] = d2; o[db][4 * rg + 3] = d3; ss += (d0 * d0 + d1 * d1) + (d2 * d2 + d3 * d3); }
    ss += __shfl_xor(ss, 32);
    const float rstd = oscale / sqrtf(ss * (1.f / 128.f) + EPS);
#pragma unroll
    for (int db = 0; db < 4; ++db)
#pragma unroll
        for (int rg = 0; rg < 4; ++rg) { const f32x4 gq = *(const f32x4*)(subg + 32 * db + 8 * rg + 4 * hi);
            *(u32x2*)(orow + 32 * db + 8 * rg) = (u32x2){cvtpk(o[db][4 * rg] * rstd * gq[0], o[db][4 * rg + 1] * rstd * gq[1]), cvtpk(o[db][4 * rg + 2] * rstd * gq[2], o[db][4 * rg + 3] * rstd * gq[3])}; }
}

namespace ml {
constexpr int QP = 144, SP = 80;
__device__ __forceinline__ int sw2(int row) { return (row >> 2) & 7; }
constexpr int O_QS = 0, O_KS = O_QS + 64 * QP * 2, O_KT = O_KS + 64 * QP * 2, O_VT = O_KT + 128 * SP * 2, O_VW = O_VT + 48 * SP * 2, O_PS = O_VW + 48 * SP * 2,
              O_CS = O_PS + 64 * SP * 2, CS_BYTES = 48 * QP * 2, O_SC = O_CS + 2 * CS_BYTES, SC_FLOATS = 384, O_END = O_SC + 2 * SC_FLOATS * 4;
static_assert(O_END <= RING_BYTES, "mlstm lds");
}
__device__ __forceinline__ void mlstm_unit(const bf16* CQK, bf16* PROJ, const float* GS, int b, int h, int dir, int sl, LAS unsigned char* lds) {
    using namespace ml;
    int tid_ = threadIdx.x; asm volatile("" : "+v"(tid_));
    const int tid = tid_, lane = tid & 63, wid = __builtin_amdgcn_readfirstlane(tid >> 6), fr = lane & 15, fq = lane >> 4;
    const int row0 = b * SEQ;
    const int hcol = (dir == 0 ? PC_Q : PC_K) + 128 * h + 32 * sl;
    LAS bf16* Qs = (LAS bf16*)(lds + O_QS); LAS bf16* Ks = (LAS bf16*)(lds + O_KS); LAS bf16* KT = (LAS bf16*)(lds + O_KT);
    LAS bf16* VT = (LAS bf16*)(lds + O_VT); LAS bf16* VW = (LAS bf16*)(lds + O_VW); LAS bf16* Ps = (LAS bf16*)(lds + O_PS);
    for (int i = tid; i < 48 * QP / 2; i += NTHR) ((LAS unsigned*)(lds + O_CS))[i] = 0u;
    for (int i = tid; i < 16 * SP / 2; i += NTHR) { ((LAS unsigned*)(VT + 32 * SP))[i] = (i < SP / 2) ? 0x3f803f80u : 0u; ((LAS unsigned*)(VW + 32 * SP))[i] = 0u; }
    f32x4 Cacc[3];
#pragma unroll
    for (int tm = 0; tm < 3; ++tm) Cacc[tm] = (f32x4){0.f, 0.f, 0.f, 0.f};
    float m_prev = 0.f;
    const int q_t = tid >> 3, q_c = tid & 7;
    const int kv_g = (tid >> 4) & 15, kv_c = tid & 15;
    const bool is_k = tid < 256, is_v = (tid >= 256 && tid < 320);
    const int v_g = (tid - 256) >> 2, v_c = (tid - 256) & 3;
    u32x4 qreg[2], kvreg[4];
    auto chunk_base = [&](int n) -> int { return dir == 0 ? row0 + 64 * n : (n < 4 ? row0 + 64 * (3 - n) : row0 + 64 * (71 - n)); };
    auto grow = [&](int rb, int tau) -> int { return dir == 0 ? rb + tau : rb + 63 - tau; };
    auto prefetch = [&](int n) {
        const int rb = chunk_base(n);
        const bf16* qp = CQK + (size_t)grow(rb, q_t) * 1024 + 128 * h + 16 * q_c;
        qreg[0] = *(const u32x4*)qp; qreg[1] = *(const u32x4*)(qp + 8);
        if (is_k) {
#pragma unroll
            for (int j = 0; j < 4; ++j) kvreg[j] = *(const u32x4*)(CQK + (size_t)grow(rb, 4 * kv_g + j) * 1024 + 512 + 128 * h + 8 * kv_c);
        } else if (is_v) {
#pragma unroll
            for (int j = 0; j < 4; ++j) kvreg[j] = *(const u32x4*)(PROJ + (size_t)grow(rb, 4 * v_g + j) * NP + PC_V + 128 * h + 32 * sl + 8 * v_c);
        }
    };
    const float* gsp = GS + (size_t)(((b * 4 + h) * 2 + dir) * 68) * 192 + lane;
    float gu = 0.f, gm = 0.f, ga = 0.f;
    auto gload = [&](int n) { gu = gsp[(size_t)n * 192]; gm = gsp[(size_t)n * 192 + 64]; ga = gsp[(size_t)n * 192 + 128]; };
    auto scalars = [&](int n) {
        LAS float* sc = (LAS float*)(lds + O_SC) + (n & 1) * SC_FLOATS;
        const float uu = gu, a = ga;
        const float M = fmaxf(m_prev, gm);
        const float M63 = __builtin_bit_cast(float, __builtin_amdgcn_readlane(__builtin_bit_cast(int, M), 63)), a63 = __builtin_bit_cast(float, __builtin_amdgcn_readlane(__builtin_bit_cast(int, a), 63));
        sc[lane] = uu; sc[64 + lane] = M; sc[128 + lane] = __expf(m_prev - M); sc[192 + lane] = __expf(-(a + M)); sc[256 + lane] = __expf(uu - M63);
        if (lane == 0) sc[320] = __expf(m_prev - M63);
        m_prev = a63 + M63;
        if (n + 1 < 68) gload(n + 1);
    };
    auto stage = [&](int n) {
        LAS const float* sc = (LAS const float*)(lds + O_SC) + (n & 1) * SC_FLOATS;
        *(LAS u32x4*)(Qs + q_t * QP + 16 * q_c) = qreg[0]; *(LAS u32x4*)(Qs + q_t * QP + 16 * q_c + 8) = qreg[1];
        if (is_k) {
#pragma unroll
            for (int j = 0; j < 4; ++j) *(LAS u32x4*)(Ks + (4 * kv_g + j) * QP + 8 * kv_c) = kvreg[j];
#pragma unroll
            for (int i = 0; i < 8; ++i) {
                const unsigned a0 = kvreg[0][i >> 1], a1 = kvreg[1][i >> 1], a2 = kvreg[2][i >> 1], a3 = kvreg[3][i >> 1];
                unsigned lo, hi2;
                if (i & 1) { lo = __builtin_amdgcn_perm(a1, a0, 0x07060302u); hi2 = __builtin_amdgcn_perm(a3, a2, 0x07060302u); }
                else { lo = __builtin_amdgcn_perm(a1, a0, 0x05040100u); hi2 = __builtin_amdgcn_perm(a3, a2, 0x05040100u); }
                *(LAS u32x2*)(KT + (8 * kv_c + i) * SP + ((((kv_g >> 1) ^ ((kv_c >> 1) & 7)) << 3) + 4 * (kv_g & 1))) = (u32x2){lo, hi2};
            }
        } else if (is_v) {
            const float w0 = sc[256 + 4 * v_g], w1 = sc[256 + 4 * v_g + 1], w2 = sc[256 + 4 * v_g + 2], w3 = sc[256 + 4 * v_g + 3];
#pragma unroll
            for (int i = 0; i < 8; ++i) {
                const unsigned a0 = kvreg[0][i >> 1], a1 = kvreg[1][i >> 1], a2 = kvreg[2][i >> 1], a3 = kvreg[3][i >> 1];
                unsigned lo, hi2; float f0, f1, f2, f3;
                if (i & 1) { lo = __builtin_amdgcn_perm(a1, a0, 0x07060302u); hi2 = __builtin_amdgcn_perm(a3, a2, 0x07060302u); f0 = bfhi(a0); f1 = bfhi(a1); f2 = bfhi(a2); f3 = bfhi(a3); }
                else { lo = __builtin_amdgcn_perm(a1, a0, 0x05040100u); hi2 = __builtin_amdgcn_perm(a3, a2, 0x05040100u); f0 = bflo(a0); f1 = bflo(a1); f2 = bflo(a2); f3 = bflo(a3); }
                const int vcol = (((v_g >> 1) ^ sw2(8 * v_c + i)) << 3) + 4 * (v_g & 1);
                *(LAS u32x2*)(VT + (8 * v_c + i) * SP + vcol) = (u32x2){lo, hi2};
                *(LAS u32x2*)(VW + (8 * v_c + i) * SP + vcol) = (u32x2){cvtpk(f0 * w0, f1 * w1), cvtpk(f2 * w2, f3 * w3)};
            }
        } else if (tid >= 320 && tid < 384) {
            VW[32 * SP + (tid - 320)] = f2bf(sc[256 + (tid - 320)]);
        }
    };
    prefetch(0);
    if (wid == 7) { gload(0); scalars(0); }
    __syncthreads();
    stage(0);
    for (int n = 0; n < 68; ++n) {
        LAS const float* sc = (LAS const float*)(lds + O_SC) + (n & 1) * SC_FLOATS;
        LAS const bf16* Cc = (LAS const bf16*)(lds + O_CS + (n & 1) * CS_BYTES);
        LAS bf16* Cn = (LAS bf16*)(lds + O_CS + ((n + 1) & 1) * CS_BYTES);
        __syncthreads();
        if (n + 1 < 68) { prefetch(n + 1); if (wid == 7) scalars(n + 1); }
        {
            const int tr = wid >> 1, tau = 16 * tr + fr; const float Mt = sc[64 + tau]; const float decay = sc[320];
            bf16x8 qa[4], kb[2][4], va[3][2], kt[2];
#pragma unroll
            for (int kk = 0; kk < 4; ++kk) { qa[kk] = *(const LAS bf16x8*)(Qs + (16 * tr + fr) * QP + 32 * kk + 8 * fq);
#pragma unroll
                for (int tt = 0; tt < 2; ++tt) kb[tt][kk] = *(const LAS bf16x8*)(Ks + (16 * (2 * (wid & 1) + tt) + fr) * QP + 32 * kk + 8 * fq); }
#pragma unroll
            for (int kk = 0; kk < 2; ++kk) { kt[kk] = *(const LAS bf16x8*)(KT + (16 * wid + fr) * SP + (((4 * kk + fq) ^ (wid & 7)) << 3));
#pragma unroll
                for (int tm = 0; tm < 3; ++tm) va[tm][kk] = *(const LAS bf16x8*)(VW + (16 * tm + fr) * SP + (((4 * kk + fq) ^ sw2(16 * tm + fr)) << 3)); }
            f32x4 s2[2] = {(f32x4){0.f, 0.f, 0.f, 0.f}, (f32x4){0.f, 0.f, 0.f, 0.f}};
#pragma unroll
            for (int tm = 0; tm < 3; ++tm) Cacc[tm] = Cacc[tm] * decay;
#pragma unroll
            for (int kk = 0; kk < 4; ++kk) {
#pragma unroll
                for (int tt = 0; tt < 2; ++tt) s2[tt] = __builtin_amdgcn_mfma_f32_16x16x32_bf16(kb[tt][kk], qa[kk], s2[tt], 0, 0, 0);
                if (kk < 2) {
#pragma unroll
                    for (int tm = 0; tm < 3; ++tm) Cacc[tm] = __builtin_amdgcn_mfma_f32_16x16x32_bf16(kt[kk], va[tm][kk], Cacc[tm], 0, 0, 0);
                }
            }
#pragma unroll
            for (int tt = 0; tt < 2; ++tt) {
                const int tc = 2 * (wid & 1) + tt;
                const int s0 = 16 * tc + 4 * fq; const f32x4 us = *(const LAS f32x4*)(sc + s0);
                float w[4];
#pragma unroll
                for (int i = 0; i < 4; ++i) w[i] = (s0 + i <= tau) ? s2[tt][i] * __expf(us[i] - Mt) : 0.f;
                *(LAS u32x2*)(Ps + tau * SP + ((((2 * tc + (fq >> 1)) ^ sw2(tau)) << 3) + 4 * (fq & 1))) = (u32x2){cvtpk(w[0], w[1]), cvtpk(w[2], w[3])};
            }
#pragma unroll
            for (int tm = 0; tm < 3; ++tm)
                *(LAS u32x2*)(Cn + (16 * tm + fr) * QP + ((((2 * wid + (fq >> 1)) ^ sw2(16 * tm + fr)) << 3) + 4 * (fq & 1))) = (u32x2){cvtpk(Cacc[tm][0], Cacc[tm][1]), cvtpk(Cacc[tm][2], Cacc[tm][3])};
        }
        __syncthreads();
        {
            const int tr = wid >> 1, tn = wid & 1, tau = 16 * tr + fr;
            f32x4 pv = (f32x4){0.f, 0.f, 0.f, 0.f}, cq = pv, pvd = pv, cqd = pv;
#pragma unroll
            for (int kk = 0; kk < 2; ++kk) {
                const bf16x8 af = *(const LAS bf16x8*)(Ps + (16 * tr + fr) * SP + (((4 * kk + fq) ^ sw2(16 * tr + fr)) << 3));
                const bf16x8 b0 = *(const LAS bf16x8*)(VT + (16 * tn + fr) * SP + (((4 * kk + fq) ^ sw2(16 * tn + fr)) << 3));
                const bf16x8 b1 = *(const LAS bf16x8*)(VT + (32 + fr) * SP + (((4 * kk + fq) ^ sw2(32 + fr)) << 3));
                pv = __builtin_amdgcn_mfma_f32_16x16x32_bf16(b0, af, pv, 0, 0, 0);
                pvd = __builtin_amdgcn_mfma_f32_16x16x32_bf16(b1, af, pvd, 0, 0, 0);
            }
#pragma unroll
            for (int kk = 0; kk < 4; ++kk) {
                const bf16x8 af = *(const LAS bf16x8*)(Qs + (16 * tr + fr) * QP + 32 * kk + 8 * fq);
                const bf16x8 b0 = *(const LAS bf16x8*)(Cc + (16 * tn + fr) * QP + (((4 * kk + fq) ^ sw2(16 * tn + fr)) << 3));
                const bf16x8 b1 = *(const LAS bf16x8*)(Cc + (32 + fr) * QP + (((4 * kk + fq) ^ sw2(32 + fr)) << 3));
                cq = __builtin_amdgcn_mfma_f32_16x16x32_bf16(b0, af, cq, 0, 0, 0);
                cqd = __builtin_amdgcn_mfma_f32_16x16x32_bf16(b1, af, cqd, 0, 0, 0);
            }
            const int rb = chunk_base(n);
            const float ai = sc[128 + tau];
            float den = (fq == 0) ? ai * cqd[0] + pvd[0] : 0.f;
            { auto r16_ = __builtin_amdgcn_permlane16_swap(__float_as_uint(den), __float_as_uint(den), false, false); den = __uint_as_float(r16_[0]) + __uint_as_float(r16_[1]); }
            { auto r32_ = __builtin_amdgcn_permlane32_swap(__float_as_uint(den), __float_as_uint(den), false, false); den = __uint_as_float(r32_[0]) + __uint_as_float(r32_[1]); }
            const float rden = 1.f / fmaxf(fabsf(den), sc[192 + tau]);
            float hv[4];
#pragma unroll
            for (int i = 0; i < 4; ++i) hv[i] = (ai * cq[i] + pv[i]) * rden;
            *(u32x2*)(PROJ + (size_t)grow(rb, tau) * NP + hcol + 16 * tn + 4 * fq) = (u32x2){cvtpk(hv[0], hv[1]), cvtpk(hv[2], hv[3])};
        }
        __syncthreads();
        if (n + 1 < 68) stage(n + 1);
    }
    __syncthreads();
}

__device__ __forceinline__ int lane_order_k(int kp) { const int t = kp & 255; return (kp & ~255) + 128 * ((t >> 3) & 1) + 32 * (t >> 6) + 16 * ((t >> 2) & 1) + 4 * ((t >> 4) & 3) + (t & 3); }
template <bool KPERM = false>
__device__ __forceinline__ void cvt_item(const float* W, int ldw, int K, int k0, int srccol0, bf16* dst, int dstrow0, LAS float* scr, int lane) {
    f32x4 wv[8];
#pragma unroll
    for (int i = 0; i < 8; ++i) { const int kk = 8 * i + (lane >> 3); const int ks = KPERM ? lane_order_k(k0 + kk) : (k0 + kk); wv[i] = *(const f32x4*)(W + (size_t)ks * ldw + srccol0 + 4 * (lane & 7)); }
#pragma unroll
    for (int i = 0; i < 8; ++i) { const int kk = 8 * i + (lane >> 3); LAS float* d = scr + kk * 33 + 4 * (lane & 7); d[0] = wv[i][0]; d[1] = wv[i][1]; d[2] = wv[i][2]; d[3] = wv[i][3]; }
    asm volatile("s_waitcnt lgkmcnt(0)" ::: "memory");
    const int c = lane & 7;
#pragma unroll
    for (int j = 0; j < 4; ++j) { const int n = (lane >> 3) + 8 * j; const LAS float* s = scr + (8 * c) * 33 + n;
        u32x4 o; o.x = cvtpk(s[0 * 33], s[1 * 33]); o.y = cvtpk(s[2 * 33], s[3 * 33]); o.z = cvtpk(s[4 * 33], s[5 * 33]); o.w = cvtpk(s[6 * 33], s[7 * 33]);
        *(u32x4*)(dst + (size_t)(dstrow0 + n) * K + k0 + 8 * c) = o; }
    asm volatile("s_waitcnt lgkmcnt(0)" ::: "memory");
}
template <int MODE, bool KPERM = false>
__device__ __forceinline__ void cvt_matrix(const float* W, int ldw, int K, int ngroups, int off, const float* W2, bf16* dst, LAS float* scr, int gw, int ngw, int lane) {
    const int kb = K / 64, items = ngroups * kb;
    for (int it = gw; it < items; it += ngw) {
        const int gidx = it / kb, k0 = 64 * (it % kb);
        const float* src = W; int sc;
        if (MODE == 0) sc = 32 * gidx + off;
        else if (MODE == 1) { const int tile = gidx >> 3, q = gidx & 7, bj = q >> 2, wc = q & 3; sc = 64 * (4 * tile + wc) + 32 * bj; }
        else { const int tile = gidx >> 3, q = gidx & 7; sc = 128 * tile + 32 * (q & 3); if (q >= 4) src = W2; }
        cvt_item<KPERM>(src, ldw, K, k0, sc, dst, 32 * gidx, scr, lane);
    }
}

__device__ __forceinline__ void load_row(const float* p, f32x4 (&v)[4], int lane) {
#pragma unroll
    for (int j = 0; j < 4; ++j) v[j] = *(const f32x4*)(p + 4 * lane + 256 * j);
}
__device__ __forceinline__ float row_rstd(const f32x4 (&v)[4]) {
    float s = 0.f;
#pragma unroll
    for (int j = 0; j < 4; ++j) s += (v[j][0] * v[j][0] + v[j][1] * v[j][1]) + (v[j][2] * v[j][2] + v[j][3] * v[j][3]);
    return 1.0f / sqrtf(wave_sum(s) * (1.f / 1024.f) + EPS);
}
__device__ __forceinline__ void norm_mod_row(f32x4 (&v)[4], const float* g, const float* sc, const float* sh, bf16* xn, int lane) {
    const float rstd = row_rstd(v);
#pragma unroll
    for (int j = 0; j < 4; ++j) {
        const int c = 4 * lane + 256 * j;
        const f32x4 gg = *(const f32x4*)(g + c), s1 = *(const f32x4*)(sc + c), s0 = *(const f32x4*)(sh + c);
        v[j] = v[j] * rstd * gg * (s1 + 1.0f) + s0;
        *(u32x2*)(xn + c) = (u32x2){cvtpk(v[j][0], v[j][1]), cvtpk(v[j][2], v[j][3])};
    }
}
__device__ __forceinline__ void load_vec(const float* p, f32x4 (&v)[4], int lane) {
#pragma unroll
    for (int j = 0; j < 4; ++j) v[j] = *(const f32x4*)(p + 4 * lane + 256 * j);
}
__device__ __forceinline__ void norm_mod_row_pre(f32x4 (&v)[4], const f32x4 (&g)[4], const f32x4 (&sc)[4], const f32x4 (&sh)[4], bf16* xn, int lane) {
    const float rstd = row_rstd(v);
#pragma unroll
    for (int j = 0; j < 4; ++j) {
        const int c = 4 * lane + 256 * j;
        v[j] = v[j] * rstd * g[j] * (sc[j] + 1.0f) + sh[j];
        *(u32x2*)(xn + c) = (u32x2){cvtpk(v[j][0], v[j][1]), cvtpk(v[j][2], v[j][3])};
    }
}
__device__ __forceinline__ void gates_row(const f32x4 (&v)[4], LAS const float* wg, const float* gate_b, float* gout, int lane) {
    float mine = 0.f;
#pragma unroll 1
    for (int q = 0; q < 16; ++q) {
        float a = 0.f;
#pragma unroll
        for (int j = 0; j < 4; ++j) { const f32x4 w = *(const LAS f32x4*)(wg + q * 1024 + 4 * lane + 256 * j); a += (v[j][0] * w[0] + v[j][1] * w[1]) + (v[j][2] * w[2] + v[j][3] * w[3]); }
        a = wave_sum(a);
        mine = (lane == q) ? a : mine;
    }
    if (lane < 16) { const float gq = mine + gate_b[lane]; gout[lane] = ((lane >> 2) & 1) ? logsigmoidf_(gq) : gq; }
}

__device__ __forceinline__ const float* in_ptr(LAS unsigned char* lds, int i) {
    unsigned off = PTAB_OFF + 8 * i; asm volatile("" : "+s"(off));
    const unsigned long long v = *(const LAS unsigned long long*)(lds + off);
    const unsigned lo = __builtin_amdgcn_readfirstlane((unsigned)v), hi = __builtin_amdgcn_readfirstlane((unsigned)(v >> 32));
    return (const float*)(const __attribute__((address_space(1))) float*)(uintptr_t)(((unsigned long long)hi << 32) | lo);
}
struct Args { const float* in[34]; float* out; unsigned char* ws; int ph_lo, ph_hi; };
constexpr int PH_PER_LAYER = 13, N_PHASES = 1 + 2 * PH_PER_LAYER;

__global__ void __launch_bounds__(NTHR, 2) mk_fwd(Args args) {
    extern __shared__ __attribute__((aligned(16))) unsigned char lds_raw[];
    LAS unsigned char* lds = (LAS unsigned char*)lds_raw;
    int tid = threadIdx.x, lane = tid & 63, wave = __builtin_amdgcn_readfirstlane(tid >> 6);
    const int G = gridDim.x, bid = blockIdx.x, ngw = G * NWAVES; int gw = bid * NWAVES + wave;
#define REFRESH() do { tid = threadIdx.x; asm volatile("" : "+v"(tid)); lane = tid & 63; wave = __builtin_amdgcn_readfirstlane(tid >> 6); gw = bid * NWAVES + wave; scr = (LAS float*)(lds + wave * 16384); } while (0)
    unsigned char* ws = args.ws;
    unsigned* ctl = (unsigned*)(ws + WS_CTL);
    volatile LAS unsigned* MISC = (volatile LAS unsigned*)(lds + MISC_OFF);
    for (int u = tid; u < (LDS_BYTES - RING_BYTES) / 4; u += NTHR) ((LAS unsigned*)(lds + RING_BYTES))[u] = 0u;
    __syncthreads();
    asm volatile("s_nop 0");
    if (tid == 0) {
#pragma unroll
        for (int i = 0; i < 34; ++i) ((LAS unsigned long long*)(lds + PTAB_OFF))[i] = (unsigned long long)(uintptr_t)args.in[i];
    }
    __syncthreads();
    const int lo = args.ph_lo, hi = args.ph_hi;
    if (hi - lo > 1) (void)xcd_barrier_post(ctl + CW_BAR, MISC + 8);
#define IN(k) (lo <= (k) && (k) < hi)
#ifndef PHM
#define PHM 0xffff
#endif
#define INJ(j) (((PHM >> (j)) & 1) && IN(pb + (j)))
#define ROWS_BEGIN(kv, rv) for (int kv = 0; kv < ((ngw == 2048) ? 17 : (R + ngw - 1) / ngw); ++kv) { const int rv = (ngw == 2048) ? (gw >> 8) * SEQ + 256 * kv + (gw & 255) : gw + kv * ngw; if (rv >= R) break;
#define ROWS_NEWMOD(kv) ((ngw != 2048) || (kv) < 2)
#define SEAM(k) do { if (IN(k) && IN((k) + 1)) { XcdBarrier b_; b_.bar = (unsigned*)(args.ws + WS_CTL) + CW_BAR; b_.x = xb_xcc_id(); b_.st = (volatile LAS unsigned*)(lds + MISC_OFF) + 8; xcd_barrier(b_); } } while (0)

#define x_in in_ptr(lds, 0)
#define c_in in_ptr(lds, 1)
#define ctx_in in_ptr(lds, 2)
#define cctx_in in_ptr(lds, 3)
    float* MOD = (float*)(ws + WS_MOD); float* ROPEC = (float*)(ws + WS_ROPE); float* ROPES = ROPEC + 1024;
    float* GATES = (float*)(ws + WS_GATES); float* CTXRES = (float*)(ws + WS_CTXRES);
    bf16* XN = (bf16*)(ws + WS_R0); bf16* CQK = (bf16*)(ws + WS_CQK); bf16* PROJ = (bf16*)(ws + WS_R1);
    bf16* AO = (bf16*)(ws + WS_AO); bf16* BO = (bf16*)(ws + WS_BO); bf16* MO = (bf16*)(ws + WS_MO);
    bf16* GB = (bf16*)(ws + WS_G); bf16* UB = (bf16*)(ws + WS_U); bf16* Y = (bf16*)(ws + WS_Y); bf16* HB = (bf16*)(ws + WS_H); bf16* Y2 = (bf16*)(ws + WS_Y2);
    LAS float* scr = (LAS float*)(lds + wave * 16384);

    for (int rep0_ = 0; rep0_ < ((((PROBE_DUP) >> 15) & 1) ? 2 : 1); ++rep0_)
    if (IN(0)) {
        REFRESH();
        LAS float* sl = (LAS float*)lds;
        for (int i = tid; i < 9 * 1024; i += NTHR) { const int j = i >> 10, k = i & 1023; const float cv = j < 8 ? c_in[j * 1024 + k] : cctx_in[k]; sl[i] = siluf_(cv); }
        __syncthreads();
        LAS float* red = (LAS float*)(lds + 40960);
        for (int un = bid; un < 192; un += G) {
            const int l = un / 96, n0 = 64 * (un % 96), ks = tid >> 6, col = tid & 63;
            const float* w = in_ptr(lds, 4) + (size_t)l * 1024 * 6144 + n0 + col;
            float a[9];
#pragma unroll
            for (int j = 0; j < 9; ++j) a[j] = 0.f;
            for (int k = ks * 128; k < ks * 128 + 128; ++k) { const float wv = w[(size_t)k * 6144];
#pragma unroll
                for (int j = 0; j < 9; ++j) a[j] += sl[j * 1024 + k] * wv; }
#pragma unroll
            for (int j = 0; j < 9; ++j) red[(ks * 9 + j) * 64 + col] = a[j];
            __syncthreads();
            for (int i = tid; i < 9 * 64; i += NTHR) { const int j = i >> 6, cc = i & 63; float s = 0.f;
#pragma unroll
                for (int k2 = 0; k2 < 8; ++k2) s += red[(k2 * 9 + j) * 64 + cc];
                MOD[((size_t)l * 9 + j) * 6144 + n0 + cc] = s + in_ptr(lds, 5)[l * 6144 + n0 + cc]; }
            __syncthreads();
        }
        if (bid == (G > 200 ? 200 : 0)) {
            for (int i = tid; i < 1024; i += NTHR) { const int p = i >> 4, f = i & 15; const float inv = powf(10000.f, -(float)f / 16.f); const float ang = (float)p * inv; float s, c; sincosf(ang, &s, &c); ROPEC[i] = c; ROPES[i] = s; }
        }
        __syncthreads();
    }
    SEAM(0);

    for (int l = 0; l < 2; ++l) {
        const int pb = 1 + PH_PER_LAYER * l;
        const bool last = (l == 1);
        const float* modl = MOD + (size_t)l * 9 * 6144;
        const float* win = in_ptr(lds, 10) + (size_t)l * D * NIN;
        const float* xres_lat = (l == 0) ? x_in : args.out;
        const float* xres_ctx = (l == 0) ? ctx_in : CTXRES;
        const float lam_init = (l == 0) ? 0.2f : (0.8f - 0.6f * 0.7408182206817179f);

#define CVT_MIXER(LL) do { const float* win_ = in_ptr(lds, 10) + (size_t)(LL) * D * NIN; const float* wa_ = in_ptr(lds, 22) + (size_t)(LL) * 512 * 1024; \
            const float* wb_ = in_ptr(lds, 23) + (size_t)(LL) * 512 * 1024; const float* wc_ = in_ptr(lds, 24) + (size_t)(LL) * 512 * 1024; const float* wo_ = in_ptr(lds, 25) + (size_t)(LL) * 1024 * 1024; \
            constexpr int J_IN = (NP / 32) * 16, J_G = (3072 / 32) * 16, J_BR = 32 * 8, J_O = 32 * 16; \
            for (int it = gw; it < J_IN + J_G + 3 * J_BR + J_O; it += ngw) { int r = it; \
                if (r < J_IN) { const int gidx = r >> 4, k0 = 64 * (r & 15), tile = gidx >> 3, q = gidx & 7; cvt_item(win_, NIN, D, k0, 64 * (4 * tile + (q & 3)) + 32 * (q >> 2), (bf16*)(ws + W_IN), 32 * gidx, scr, lane); continue; } r -= J_IN; \
                if (r < J_G) { const int gidx = r >> 4, k0 = 64 * (r & 15); cvt_item(win_, NIN, D, k0, 4368 + 32 * gidx, (bf16*)(ws + W_G), 32 * gidx, scr, lane); continue; } r -= J_G; \
                if (r < 3 * J_BR) { const int br = r / J_BR, q = r - br * J_BR, gidx = q >> 3, k0 = 64 * (q & 7); cvt_item(br == 0 ? wa_ : (br == 1 ? wb_ : wc_), 1024, 512, k0, 32 * gidx, (bf16*)(ws + W_A) + (size_t)br * 512 * 1024, 32 * gidx, scr, lane); continue; } r -= 3 * J_BR; \
                { const int gidx = r >> 4, k0 = 64 * (r & 15); cvt_item<true>(wo_, 1024, 1024, k0, 32 * gidx, (bf16*)(ws + W_O), 32 * gidx, scr, lane); } } } while (0)
        REP(0) if (INJ(0) && l == 0) {
            REFRESH();
            CVT_MIXER(0);
            __syncthreads();
            LAS float* wg = (LAS float*)lds;
            for (int i = tid; i < 16 * 1024; i += NTHR) { const int k = i >> 4, q = i & 15; wg[q * 1024 + k] = win[(size_t)k * NIN + 4352 + q]; }
            __syncthreads();
            const float* xin_p = x_in; const float* cin_p = ctx_in; const float* pmg_h = in_ptr(lds, 6) + l * D; const float* gbp_h = in_ptr(lds, 20) + l * 16;
            f32x4 mgv[4]; load_vec(pmg_h, mgv, lane);
            f32x4 scv[4], shv[4];
#pragma unroll
            for (int j = 0; j < 4; ++j) { scv[j] = (f32x4){0.f, 0.f, 0.f, 0.f}; shv[j] = scv[j]; }
            ROWS_BEGIN(kr, r)
                const int b = r / SEQ, pos = r % SEQ; const bool isc = pos < NCTX;
                const float* xr = isc ? cin_p + ((size_t)b * NCTX + pos) * D : xin_p + ((size_t)b * TLAT + pos - NCTX) * D;
                const float* md = modl + (size_t)(isc ? 8 : b) * 6144;
                f32x4 v[4]; load_row(xr, v, lane); if (ROWS_NEWMOD(kr)) { load_vec(md + 1024, scv, lane); load_vec(md, shv, lane); }
                norm_mod_row_pre(v, mgv, scv, shv, XN + (size_t)r * D, lane);
                gates_row(v, wg, gbp_h, GATES + (size_t)r * 16, lane);
            }
            __syncthreads();
        }
        if (l == 0) SEAM(pb + 0);

        REP(1) if (INJ(1)) {
            REFRESH();
            pg8::GemmP g{D, D, D}; InProjOrder S; S.G = G; S.c = bid; S.skip = last ? 1 : 0; S.A = (const char*)XN; S.B = (const char*)(ws + W_IN);
            LAS float* etab = (LAS float*)(lds + RING_BYTES + 4096);
            { const float* qgp = in_ptr(lds, 11) + l * 64; const float* kgp = in_ptr(lds, 12) + l * 64;
              for (int i = tid; i < 2176; i += NTHR) etab[i] = i < 2048 ? ROPEC[i] : (i < 2112 ? qgp[i - 2048] : kgp[i - 2112]); }
            __syncthreads();
            EpiInProj E{PROJ, etab + 2048, etab + 2112, etab, etab + 1024};
            pg8::gemm_phase(lds, g, S, E);
        }
        SEAM(pb + 1);

        REP(2) if (INJ(2)) {
            REFRESH();
            const int c8 = tid & 127, rsub = tid >> 7;
            const float* cw = in_ptr(lds, 18) + (size_t)l * 3 * 1024 + 8 * c8; const float* cb = in_ptr(lds, 19) + (size_t)l * 1024 + 8 * c8;
            float w0[8], w1[8], w2[8], bb[8];
#pragma unroll
            for (int i = 0; i < 8; ++i) { w0[i] = cw[i]; w1[i] = cw[1024 + i]; w2[i] = cw[2048 + i]; bb[i] = cb[i]; }
            const float ksc = c8 >= 64 ? 0.08838834764831845f : 1.f;
            const int nwk = G * 4, rpw = (R + nwk - 1) / nwk, r0 = (bid * 4 + rsub) * rpw, r1 = (r0 + rpw < R) ? r0 + rpw : R;
            for (int r = r0; r < r1; r += 4) {
                u32x4 xw[6];
#pragma unroll
                for (int k = 0; k < 6; ++k) { const int rr = r - 1 + k; const bool ok = (rr >= 0 && rr < R); const int rc = ok ? rr : r;
                    xw[k] = *(const u32x4*)(PROJ + (size_t)rc * NP + PC_Q + 8 * c8); if (!ok) xw[k] = (u32x4){0u, 0u, 0u, 0u}; }
#pragma unroll
                for (int k = 0; k < 4; ++k) { const int row = r + k;
                    if (row < r1) {
                        const int pos = row % SEQ;
                        const bool hasl = !(pos == 0 || pos == NCTX), hasr = !(pos == NCTX - 1 || pos == SEQ - 1);
                        const u32x4 z4 = (u32x4){0u, 0u, 0u, 0u};
                        const u32x4 xl = hasl ? xw[k] : z4, xc = xw[k + 1], xr = hasr ? xw[k + 2] : z4;
                        float o[8];
#pragma unroll
                        for (int i = 0; i < 8; ++i) {
                            const float a = (i & 1) ? bfhi(xl[i >> 1]) : bflo(xl[i >> 1]), bq = (i & 1) ? bfhi(xc[i >> 1]) : bflo(xc[i >> 1]), cq = (i & 1) ? bfhi(xr[i >> 1]) : bflo(xr[i >> 1]);
                            o[i] = siluf_(a * w0[i] + bq * w1[i] + cq * w2[i] + bb[i]) * ksc;
                        }
                        *(u32x4*)(CQK + (size_t)row * 1024 + 8 * c8) = (u32x4){cvtpk(o[0], o[1]), cvtpk(o[2], o[3]), cvtpk(o[4], o[5]), cvtpk(o[6], o[7])};
                    } }
            }
        }
        if (INJ(2)) {
            float* GSw = (float*)(ws + WS_MO);
            for (int task = gw; task < NB * 4 * 2 * 68; task += ngw) {
                const int n = task % 68, chain = task / 68, dir = chain & 1, h = (chain >> 1) & 3, b = chain >> 3;
                const int row0 = b * SEQ;
                const int rb = dir == 0 ? row0 + 64 * n : (n < 4 ? row0 + 64 * (3 - n) : row0 + 64 * (71 - n));
                const int row = dir == 0 ? rb + lane : rb + 63 - lane;
                const float* gp = GATES + (size_t)row * 16 + (dir == 0 ? 0 : 8) + h;
                const float ig = gp[0], lf = gp[4];
                float a = lf;
#pragma unroll
                for (int o = 1; o < 64; o <<= 1) { const float t = __shfl_up(a, o); if (lane >= o) a += t; }
                const float uu = ig - a;
                float mloc = uu;
#pragma unroll
                for (int o = 1; o < 64; o <<= 1) { const float t = __shfl_up(mloc, o); if (lane >= o) mloc = fmaxf(mloc, t); }
                float* o3 = GSw + (size_t)task * 192 + lane;
                o3[0] = uu; o3[64] = mloc; o3[128] = a;
            }
        }
        SEAM(pb + 2);

        REP(3) if (INJ(3)) {
            REFRESH();
            const bool x8 = (G == 256);
            const int vcu = x8 ? (bid & 7) * 32 + (bid >> 3) : bid;
#ifndef NO_MLSTM
            for (int rp_ = 0; rp_ < PROBE_ML; ++rp_)
            for (int id = vcu; id < 256; id += G) { const int chain = id >> 2; mlstm_unit(CQK, PROJ, (const float*)(ws + WS_MO), chain >> 3, (chain >> 1) & 3, chain & 1, id & 3, lds); }
#endif
            if (IN(pb + 3)) { XcdBarrier b_; b_.bar = (unsigned*)(args.ws + WS_CTL) + CW_BAR; b_.x = xb_xcc_id(); b_.st = (volatile LAS unsigned*)(lds + MISC_OFF) + 8; xcd_barrier(b_); }
            REFRESH();
            {
            const float* ng = in_ptr(lds, 21) + l * 128;
            float ngv[8];
#pragma unroll
            for (int i = 0; i < 8; ++i) ngv[i] = ng[(8 * lane + i) & 127];
            for (int r = gw; r < R; r += ngw) {
                const bf16* pr = PROJ + (size_t)r * NP;
                const u32x4 hf = *(const u32x4*)(pr + PC_Q + 8 * lane), hb = *(const u32x4*)(pr + PC_K + 8 * lane), op = *(const u32x4*)(pr + PC_O + 8 * lane);
                float hs[8]; float ss = 0.f;
#pragma unroll
                for (int i = 0; i < 8; ++i) { hs[i] = ((i & 1) ? bfhi(hf[i >> 1]) : bflo(hf[i >> 1])) + ((i & 1) ? bfhi(hb[i >> 1]) : bflo(hb[i >> 1])); ss += hs[i] * hs[i]; }
                ss = row16_sum(ss);
                const float rstd = 1.0f / sqrtf(ss * (1.f / 128.f) + EPS);
                float o[8];
#pragma unroll
                for (int i = 0; i < 8; ++i) { const float og = (i & 1) ? bfhi(op[i >> 1]) : bflo(op[i >> 1]); o[i] = hs[i] * rstd * ngv[i] * sigmoidf_(og); }
                *(u32x4*)(MO + (size_t)r * 512 + 8 * lane) = (u32x4){cvtpk(o[0], o[1]), cvtpk(o[2], o[3]), cvtpk(o[4], o[5]), cvtpk(o[6], o[7])};
            }
            }
            float lam;
            { const float p1 = wave_sum(in_ptr(lds, 13)[l * 64 + lane] * in_ptr(lds, 14)[l * 64 + lane]), p2 = wave_sum(in_ptr(lds, 15)[l * 64 + lane] * in_ptr(lds, 16)[l * 64 + lane]); lam = __expf(p1) - __expf(p2) + lam_init; }
            const float* subg = in_ptr(lds, 17) + l * 128;
            for (int k = 0, id = vcu; id < 512; id += G, ++k) { int b = id >> 6, hh = (id >> 4) & 3, qb = id & 15;
                if (x8) { const int grp = 4 * (vcu >> 5) + (k >> 0) * 2 + ((vcu & 31) >> 4); b = grp >> 2; hh = grp & 3; qb = vcu & 15; }
#ifndef NO_ATTNB
                attn_unit_b(PROJ, BO, b * SEQ + NCTX + 256 * qb, b * SEQ, 68, hh, lam, 1.f - lam_init, subg, lds);
#endif
 }
            for (int k = 0, id = vcu; id < 1024; id += G, ++k) { int b = id >> 7, h = (id >> 4) & 7, qb = id & 15;
                if (x8) { const int grp = 2 * (vcu >> 5) + (k >> 1), u = (vcu & 31) + 32 * (k & 1); b = grp >> 1; h = 4 * (grp & 1) + (u >> 4); qb = u & 15; }
#ifndef NO_ATTNA
                attn_unit_a(PROJ, AO, b * SEQ + NCTX + 256 * qb, b * SEQ, 68, h, lds);
#endif
 }
            if (!last) {
                for (int id = bid; id < 96; id += G) {
#ifndef NO_ATTNC
                    if (id < 64) attn_unit_a(PROJ, AO, (id >> 3) * SEQ, (id >> 3) * SEQ, 4, id & 7, lds);
                    else { const int j = id - 64; attn_unit_b(PROJ, BO, (j >> 2) * SEQ, (j >> 2) * SEQ, 4, j & 3, lam, 1.f - lam_init, subg, lds); }
#endif
                }
            }
        }
        SEAM(pb + 3);


        REP(5) if (INJ(5)) {
            REFRESH();
            pg8::GemmP g{D, D, D}; pg8::StaticOrder S; S.init(R, 3072, G, bid, XN, D, ws + W_G, D, last ? 1 : 0);
            EpiSigmoid E{GB, 3072};
            pg8::gemm_phase(lds, g, S, E);
        }
        SEAM(pb + 5);

        REP(6) if (INJ(6)) {
            REFRESH();
            pg8::GemmP g{512, 512, 512}; MergeOrder S; S.lat = last ? 1 : 0; S.nM = last ? 128 : R / 256; S.nN = 4; S.nwg = S.nM * 4; S.G = G; S.c = bid;
            S.A0 = (const char*)AO; S.B0 = (const char*)(ws + W_A);
            EpiMerge E{GB, UB};
            pg8::gemm_phase(lds, g, S, E);
        }
        SEAM(pb + 6);

        REP(7) if (INJ(7)) {
            REFRESH();
            pg8::GemmP g{D, D, D}; pg8::StaticOrder S; S.init(R, D, G, bid, UB, D, ws + W_O, D, last ? 1 : 0);
            EpiBf16 E{Y, D};
            pg8::gemm_phase(lds, g, S, E);
            if (!last && bid >= 32) {
                REFRESH();
                const int cw = (bid - 32) * NWAVES + wave, ncw = (G - 32) * NWAVES;
                const float* wgp = in_ptr(lds, 26); const float* wup = in_ptr(lds, 27); const float* wdp = in_ptr(lds, 28);
                constexpr int I_GU = (2 * DFF / 32) * (D / 64), I_D = (D / 32) * (DFF / 64);
                for (int it = cw; it < I_GU + I_D; it += ncw) { int r = it;
                    if (r < I_GU) { const int gidx = r / (D / 64), k0 = 64 * (r % (D / 64)), tile = gidx >> 3, q = gidx & 7;
                        cvt_item((q >= 4 ? wup : wgp), DFF, D, k0, 128 * tile + 32 * (q & 3), (bf16*)(ws + WFF_GU), 32 * gidx, scr, lane); }
                    else { r -= I_GU; const int gidx = r / (DFF / 64), k0 = 64 * (r % (DFF / 64)); cvt_item(wdp, D, DFF, k0, 32 * gidx, (bf16*)(ws + WFF_D), 32 * gidx, scr, lane); } }
            }
        }
        SEAM(pb + 7);

        for (int rep_ = 0; rep_ < ((((PROBE_DUP) >> 8) & 1) && !last ? 2 : 1); ++rep_) if (INJ(8)) {
            REFRESH();
            LAS float* wrl = (LAS float*)lds;
            if (last) { for (int i = tid; i < 8 * 1024; i += NTHR) { const int k = i >> 3, e = i & 7; wrl[e * 1024 + k] = in_ptr(lds, 29)[(size_t)k * 8 + e]; } __syncthreads(); }
            int* TOKE = (int*)(ws + MOE_TOKE); int* TOKP = (int*)(ws + MOE_TOKP); float* TOKW = (float*)(ws + MOE_TOKW);
            int wcn[8] = {0, 0, 0, 0, 0, 0, 0, 0}; int nrw = 0, sv_t = 0, sv_e = 0, sv_p = 0; float sv_w = 0.f;
            const float* pog_h = in_ptr(lds, 7) + l * D; const float* pfg_h = in_ptr(lds, 8) + l * D; const float* brp_h = in_ptr(lds, 30);
            f32x4 pgv[4], fgv[4]; load_vec(pog_h, pgv, lane); load_vec(pfg_h, fgv, lane);
            f32x4 g1v[4], scv[4], shv[4];
#pragma unroll
            for (int j = 0; j < 4; ++j) { g1v[j] = (f32x4){0.f, 0.f, 0.f, 0.f}; scv[j] = g1v[j]; shv[j] = g1v[j]; }
            ROWS_BEGIN(kr, r)
                const int b = r / SEQ, pos = r % SEQ; const bool isc = pos < NCTX;
                if (isc && last) continue;
                const float* xr = isc ? xres_ctx + ((size_t)b * NCTX + pos) * D : xres_lat + ((size_t)b * TLAT + pos - NCTX) * D;
                float* xo = isc ? CTXRES + ((size_t)b * NCTX + pos) * D : args.out + ((size_t)b * TLAT + pos - NCTX) * D;
                const float* md = modl + (size_t)(isc ? 8 : b) * 6144;
                f32x4 y[4], v[4];
                { u32x2 yb[4];
#pragma unroll
                  for (int j = 0; j < 4; ++j) yb[j] = *(const u32x2*)(Y + (size_t)r * D + 4 * lane + 256 * j);
#pragma unroll
                  for (int j = 0; j < 4; ++j) y[j] = (f32x4){bflo(yb[j].x), bfhi(yb[j].x), bflo(yb[j].y), bfhi(yb[j].y)}; }
                load_row(xr, v, lane); if (ROWS_NEWMOD(kr)) { load_vec(md + 2048, g1v, lane); load_vec(md + 4096, scv, lane); load_vec(md + 3072, shv, lane); }
                const float rstd = row_rstd(y);
#pragma unroll
                for (int j = 0; j < 4; ++j) { const int c = 4 * lane + 256 * j;
                    v[j] = v[j] + g1v[j] * (y[j] * rstd * pgv[j]); *(f32x4*)(xo + c) = v[j]; }
                norm_mod_row_pre(v, fgv, scv, shv, XN + (size_t)r * D, lane);
                if (last) {
                    float lg[8];
#pragma unroll
                    for (int e = 0; e < 8; ++e) { float a = 0.f;
#pragma unroll
                        for (int j = 0; j < 4; ++j) { const f32x4 w = *(const LAS f32x4*)(wrl + e * 1024 + 4 * lane + 256 * j); a += (v[j][0] * w[0] + v[j][1] * w[1]) + (v[j][2] * w[2] + v[j][3] * w[3]); }
                        lg[e] = wave_sum(a) + brp_h[e]; }
                    int e0 = 0; float v0 = lg[0];
#pragma unroll
                    for (int e = 1; e < 8; ++e) if (lg[e] > v0) { v0 = lg[e]; e0 = e; }
                    int e1 = -1; float v1 = -INFINITY;
#pragma unroll
                    for (int e = 0; e < 8; ++e) if (e != e0 && lg[e] > v1) { v1 = lg[e]; e1 = e; }
                    const float w1 = 1.f / (1.f + __expf(v0 - v1)), w0 = 1.f - w1;
                    int lp0 = 0, lp1 = 0;
#pragma unroll
                    for (int e = 0; e < 8; ++e) { if (e == e0) { lp0 = wcn[e]; wcn[e] += 1; } if (e == e1) { lp1 = wcn[e]; wcn[e] += 1; } }
                    if (lane == nrw) { sv_t = b * TLAT + pos - NCTX; sv_e = e0 | (e1 << 8); sv_p = lp0 | (lp1 << 16); sv_w = w0; }
                    ++nrw;
                }
            }
            if (last) {
                LAS int* wcl = (LAS int*)(lds + 65536);
                int mycnt = 0;
#pragma unroll
                for (int e = 0; e < 8; ++e) mycnt = (lane == e) ? wcn[e] : mycnt;
                if (lane < 8) wcl[wave * 8 + lane] = mycnt;
                __syncthreads();
                if (wave == 0 && lane < 8) { int tot = 0;
#pragma unroll
                    for (int w = 0; w < 8; ++w) tot += wcl[w * 8 + lane];
                    int base = (int)atomicAdd(ctl + CW_CNT + 64 * lane, (unsigned)tot);
#pragma unroll
                    for (int w = 0; w < 8; ++w) { const int c = wcl[w * 8 + lane]; wcl[64 + w * 8 + lane] = base; base += c; } }
                __syncthreads();
                if (lane < nrw) { const int e0 = sv_e & 255, e1 = sv_e >> 8;
                    TOKE[2 * sv_t] = e0; TOKE[2 * sv_t + 1] = e1; TOKP[2 * sv_t] = wcl[64 + wave * 8 + e0] + (sv_p & 0xffff); TOKP[2 * sv_t + 1] = wcl[64 + wave * 8 + e1] + (sv_p >> 16);
                    TOKW[2 * sv_t] = sv_w; TOKW[2 * sv_t + 1] = 1.f - sv_w; }
            }
            __syncthreads();
        }
        SEAM(pb + 8);

        if (!last) {
            REP(9) if (INJ(9)) {
            REFRESH();
                pg8::GemmP g{D, D, D}; pg8::StaticOrder S; S.init(R, 2 * DFF, G, bid, XN, D, ws + WFF_GU, D);
                EpiSwiGLU E{HB, DFF};
                pg8::gemm_phase(lds, g, S, E);
            }
            SEAM(pb + 9);
            REP(10) if (INJ(10)) {
            REFRESH();
                pg8::GemmP g{DFF, DFF, DFF}; pg8::StaticOrder S; S.init(R, D, G, bid, HB, DFF, ws + WFF_D, DFF);
                EpiBf16 E{Y2, D};
                pg8::gemm_phase(lds, g, S, E);
            }
            SEAM(pb + 10);
            if (INJ(11)) {
            REFRESH();
                CVT_MIXER(1);
                __syncthreads();
                const float* win1 = in_ptr(lds, 10) + (size_t)D * NIN;
                const float* mod1 = MOD + (size_t)9 * 6144;
                LAS float* wg = (LAS float*)lds;
                for (int i = tid; i < 16 * 1024; i += NTHR) { const int k = i >> 4, q = i & 15; wg[q * 1024 + k] = win1[(size_t)k * NIN + 4352 + q]; }
                __syncthreads();
                const float* pfg_h = in_ptr(lds, 9) + l * D; const float* pmg1_h = in_ptr(lds, 6) + D; const float* gbp1_h = in_ptr(lds, 20) + 16;
                f32x4 pgv[4], mgv[4]; load_vec(pfg_h, pgv, lane); load_vec(pmg1_h, mgv, lane);
                f32x4 g2v[4], scv[4], shv[4];
#pragma unroll
                for (int j = 0; j < 4; ++j) { g2v[j] = (f32x4){0.f, 0.f, 0.f, 0.f}; scv[j] = g2v[j]; shv[j] = g2v[j]; }
                ROWS_BEGIN(kr, r)
                    const int b = r / SEQ, pos = r % SEQ; const bool isc = pos < NCTX;
                    float* xo = isc ? CTXRES + ((size_t)b * NCTX + pos) * D : args.out + ((size_t)b * TLAT + pos - NCTX) * D;
                    const float* md = modl + (size_t)(isc ? 8 : b) * 6144;
                    const float* md1 = mod1 + (size_t)(isc ? 8 : b) * 6144;
                    f32x4 y[4], v[4]; load_row(xo, v, lane);
                    if (ROWS_NEWMOD(kr)) { load_vec(md + 5120, g2v, lane); load_vec(md1 + 1024, scv, lane); load_vec(md1, shv, lane); }
#pragma unroll
                    for (int j = 0; j < 4; ++j) { const u32x2 a = *(const u32x2*)(Y2 + (size_t)r * D + 4 * lane + 256 * j); y[j] = (f32x4){bflo(a.x), bfhi(a.x), bflo(a.y), bfhi(a.y)}; }
                    const float rstd = row_rstd(y);
#pragma unroll
                    for (int j = 0; j < 4; ++j) { const int c = 4 * lane + 256 * j;
                        v[j] = v[j] + g2v[j] * (y[j] * rstd * pgv[j]); *(f32x4*)(xo + c) = v[j]; }
                    norm_mod_row_pre(v, mgv, scv, shv, XN + (size_t)r * D, lane);
                    gates_row(v, wg, gbp1_h, GATES + (size_t)r * 16, lane);
                }
                __syncthreads();
            }
            SEAM(pb + 11);
        } else {
            int* TOKE = (int*)(ws + MOE_TOKE); int* TOKP = (int*)(ws + MOE_TOKP); float* TOKW = (float*)(ws + MOE_TOKW);
            int* ROWSLOT = (int*)(ws + MOE_ROWSLOT); float* ROWW = (float*)(ws + MOE_ROWW);
            bf16* XG = (bf16*)(ws + WS_XG); bf16* HM = (bf16*)(ws + WS_HM); bf16* YS = (bf16*)(ws + WS_YS);
            REP(9) if (INJ(9)) {
            REFRESH();
                int tb[NEXP + 1], cnt[NEXP]; tb[0] = 0;
#pragma unroll
                for (int e = 0; e < NEXP; ++e) { cnt[e] = (int)__hip_atomic_load(ctl + CW_CNT + 64 * e, __ATOMIC_RELAXED, __HIP_MEMORY_SCOPE_AGENT); tb[e + 1] = tb[e] + (cnt[e] + 255) / 256; }
                for (int pr0 = gw * 4; pr0 < 2 * NB * TLAT; pr0 += ngw * 4) {
                    int rowq[4]; u32x4 va[4], vb[4];
#pragma unroll
                    for (int q = 0; q < 4; ++q) { const int pr = pr0 + q; const int e = TOKE[pr] & 7, p = TOKP[pr] & 0x7fff;
                        int base = 0;
#pragma unroll
                        for (int j = 0; j < NEXP; ++j) base = (j == e) ? tb[j] : base;
                        rowq[q] = min(base * 256 + p, XG_ROWS - 1); }
#pragma unroll
                    for (int q = 0; q < 4; ++q) { const int t = (pr0 + q) >> 1; const int b = t / TLAT, tt = t % TLAT; const size_t srow = (size_t)b * SEQ + NCTX + tt;
                        const u32x4* src = (const u32x4*)(XN + srow * D); va[q] = src[lane]; vb[q] = src[lane + 64]; }
#pragma unroll
                    for (int q = 0; q < 4; ++q) { u32x4* dst = (u32x4*)(XG + (size_t)rowq[q] * D); dst[lane] = va[q]; dst[lane + 64] = vb[q];
                        if (lane == 0) { ROWSLOT[rowq[q]] = pr0 + q; ROWW[rowq[q]] = TOKW[pr0 + q]; } }
                }
#pragma unroll
                for (int e = 0; e < NEXP; ++e) {
                    const int r0 = tb[e] * 256 + cnt[e], r1 = tb[e + 1] * 256;
                    for (int row = r0 + gw; row < r1; row += ngw) { u32x4* dst = (u32x4*)(XG + (size_t)row * D); unsigned z0 = 0u; asm volatile("" : "+v"(z0)); const u32x4 zz = (u32x4){z0, z0, z0, z0}; dst[lane] = zz; dst[lane + 64] = zz; if (lane == 0) { ROWSLOT[row] = -1; ROWW[row] = 0.f; } }
                }
                {
                    const float* wgp = in_ptr(lds, 31); const float* wup = in_ptr(lds, 32); const float* wdp = in_ptr(lds, 33);
                    constexpr int I_GU = (2 * DFE / 32) * (D / 64), I_D = (D / 32) * (DFE / 64), I_E = I_GU + I_D;
                    for (int it = gw; it < NEXP * I_E; it += ngw) {
                        const int e = it / I_E; int r = it - e * I_E;
                        if (r < I_GU) { const int gidx = r / (D / 64), k0 = 64 * (r % (D / 64)), tile = gidx >> 3, q = gidx & 7;
                            cvt_item((q >= 4 ? wup : wgp) + (size_t)e * D * DFE, DFE, D, k0, 128 * tile + 32 * (q & 3), (bf16*)(ws + WM_GU) + (size_t)e * 2 * DFE * D, 32 * gidx, scr, lane); }
                        else { r -= I_GU; const int gidx = r / (DFE / 64), k0 = 64 * (r % (DFE / 64));
                            cvt_item(wdp + (size_t)e * DFE * D, D, DFE, k0, 32 * gidx, (bf16*)(ws + WM_D) + (size_t)e * D * DFE, 32 * gidx, scr, lane); }
                    }
                }
                __syncthreads();
            }
            SEAM(pb + 9);
            REP(10) if (INJ(10)) {
            REFRESH();
                pg8::GemmP g{D, D, D}; MoeOrder S; S.tb[0] = 0;
#pragma unroll
                for (int e = 0; e < NEXP; ++e) { const int c = (int)__hip_atomic_load(ctl + CW_CNT + 64 * e, __ATOMIC_RELAXED, __HIP_MEMORY_SCOPE_AGENT); S.tb[e + 1] = S.tb[e] + (c + 255) / 256; }
                S.nN = 2 * DFE / 256; S.G = G; S.c = bid; S.A = (const char*)XG; S.B = (const char*)(ws + WM_GU); S.ta = (size_t)256 * D * 2; S.tb_tile = (size_t)256 * D * 2; S.tb_exp = (size_t)2 * DFE * D * 2;
                EpiSwiGLU E{HM, DFE};
                pg8::gemm_phase(lds, g, S, E);
            }
            SEAM(pb + 10);
            REP(11) if (INJ(11)) {
            REFRESH();
                pg8::GemmP g{DFE, DFE, DFE}; MoeOrder S; S.tb[0] = 0;
#pragma unroll
                for (int e = 0; e < NEXP; ++e) { const int c = (int)__hip_atomic_load(ctl + CW_CNT + 64 * e, __ATOMIC_RELAXED, __HIP_MEMORY_SCOPE_AGENT); S.tb[e + 1] = S.tb[e] + (c + 255) / 256; }
                S.nN = 4; S.G = G; S.c = bid; S.A = (const char*)HM; S.B = (const char*)(ws + WM_D); S.ta = (size_t)256 * DFE * 2; S.tb_tile = (size_t)256 * DFE * 2; S.tb_exp = (size_t)D * DFE * 2;
                EpiMoeDown E{YS, ROWSLOT, ROWW};
                pg8::gemm_phase(lds, g, S, E);
            }
            SEAM(pb + 11);
            REP(12) if (INJ(12)) {
            REFRESH();
                const float* pfg_h = in_ptr(lds, 9) + l * D;
                f32x4 pgv[4]; load_vec(pfg_h, pgv, lane);
                const bool contig = (ngw == 2048);
                f32x4 g0[4], g1[4];
#pragma unroll
                for (int j = 0; j < 4; ++j) { g0[j] = (f32x4){0.f, 0.f, 0.f, 0.f}; g1[j] = g0[j]; }
                for (int ip = 0; ip < (contig ? 8 : (NB * TLAT + 2 * ngw - 1) / (2 * ngw)); ++ip) {
                    const int t0 = contig ? (gw >> 8) * TLAT + 512 * ip + (gw & 255) : gw + 2 * ip * ngw; if (t0 >= NB * TLAT) break;
                    const int t1 = contig ? t0 + 256 : t0 + ngw; const bool h1 = t1 < NB * TLAT; const int t1c = h1 ? t1 : t0;
                    float* xo0 = args.out + (size_t)t0 * D; float* xo1 = args.out + (size_t)t1c * D;
                    f32x4 v0[4], v1[4]; u32x2 a0[4], b0[4], a1[4], b1[4];
                    load_row(xo0, v0, lane); load_row(xo1, v1, lane);
                    if (!contig || ip == 0) { load_vec(modl + (size_t)(t0 / TLAT) * 6144 + 5120, g0, lane); load_vec(modl + (size_t)(t1c / TLAT) * 6144 + 5120, g1, lane); }
#pragma unroll
                    for (int j = 0; j < 4; ++j) { const int c = 4 * lane + 256 * j;
                        a0[j] = *(const u32x2*)(YS + (size_t)(2 * t0) * D + c); b0[j] = *(const u32x2*)(YS + (size_t)(2 * t0 + 1) * D + c);
                        a1[j] = *(const u32x2*)(YS + (size_t)(2 * t1c) * D + c); b1[j] = *(const u32x2*)(YS + (size_t)(2 * t1c + 1) * D + c); }
                    f32x4 y0[4], y1[4];
#pragma unroll
                    for (int j = 0; j < 4; ++j) {
                        y0[j] = (f32x4){bflo(a0[j].x) + bflo(b0[j].x), bfhi(a0[j].x) + bfhi(b0[j].x), bflo(a0[j].y) + bflo(b0[j].y), bfhi(a0[j].y) + bfhi(b0[j].y)};
                        y1[j] = (f32x4){bflo(a1[j].x) + bflo(b1[j].x), bfhi(a1[j].x) + bfhi(b1[j].x), bflo(a1[j].y) + bflo(b1[j].y), bfhi(a1[j].y) + bfhi(b1[j].y)}; }
                    const float r0 = row_rstd(y0), r1 = row_rstd(y1);
#pragma unroll
                    for (int j = 0; j < 4; ++j) { const int c = 4 * lane + 256 * j;
                        *(f32x4*)(xo0 + c) = v0[j] + g0[j] * (y0[j] * r0 * pgv[j]);
                        if (h1) *(f32x4*)(xo1 + c) = v1[j] + g1[j] * (y1[j] * r1 * pgv[j]); }
                }
            }
        }
    }
#undef IN
#undef SEAM
#undef CVT_MIXER
}

extern "C" void kernel_launch(void* const* d_in, const int* in_sizes, int n_in, void* d_out, int out_size, void* d_ws, size_t ws_size, hipStream_t stream) {
    static int grid = 0;
    if (grid == 0) {
        if (n_in != 34 || out_size != NB * TLAT * D || ws_size < WS_END) { fprintf(stderr, "kernel_launch: unexpected problem (n_in %d out %d ws %zu)\n", n_in, out_size, ws_size); grid = -1; return; }
        int dev = 0, cus = 0, per_cu = 0;
        if (hipGetDevice(&dev) != hipSuccess || hipDeviceGetAttribute(&cus, hipDeviceAttributeMultiprocessorCount, dev) != hipSuccess) { grid = -1; return; }
        if (hipFuncSetAttribute((const void*)mk_fwd, hipFuncAttributeMaxDynamicSharedMemorySize, LDS_BYTES) != hipSuccess) { fprintf(stderr, "kernel_launch: hipFuncSetAttribute failed\n"); grid = -1; return; }
        if (hipOccupancyMaxActiveBlocksPerMultiprocessor(&per_cu, (const void*)mk_fwd, NTHR, LDS_BYTES) != hipSuccess || per_cu < 1) fprintf(stderr, "kernel_launch: occupancy query says %d\n", per_cu);
        (void)hipGetLastError();
        grid = cus;
    }
    if (grid < 0) return;
    if (hipMemsetAsync((char*)d_ws + WS_CTL, 0, CTL_BYTES, stream) != hipSuccess) return;
    Args a{};
    for (int i = 0; i < 34; ++i) a.in[i] = (const float*)d_in[i];
    a.out = (float*)d_out; a.ws = (unsigned char*)d_ws;
#if MK_SINGLE
    a.ph_lo = 0; a.ph_hi = N_PHASES;
    hipLaunchKernelGGL(mk_fwd, dim3(grid), dim3(NTHR), LDS_BYTES, stream, a);
#else
    for (int p = 0; p < N_PHASES; ++p) { a.ph_lo = p; a.ph_hi = p + 1; hipLaunchKernelGGL(mk_fwd, dim3(grid), dim3(NTHR), LDS_BYTES, stream, a); }
#endif
}
```
